# Optimizing an MI355X kernel written in HIP

```python
import jax, jax.numpy as jnp
from jax import lax
import numpy as np

D_MODEL = 1024
BATCH = 16
SEQ = 256
DEPTH = 2
DEC_BATCH = 8
DEC_SEQ = 4096
PAST_LEN = 512

GRID_W = 64
HEAD_DIM = 64
ATTN_WIDTH = D_MODEL // 2
N_HEADS = ATTN_WIDTH // HEAD_DIM
N_KV_HEADS = 2
GQA_GROUP = N_HEADS // N_KV_HEADS
KV_WIDTH = N_KV_HEADS * HEAD_DIM
POOL_WIDTH = D_MODEL // 4
POOL_WINDOWS = (2, 4, 8, 16)
POOL_GROUP = POOL_WIDTH // len(POOL_WINDOWS)
CONV_WIDTH = D_MODEL // 4
CONV_K = 3
WINDOW = 128
BLOCK = 128
D_FF = 2816
ROPE_BASE = 10000.0
EPS = 1e-6
NEG = -1e30
N_MOD = 9
MIX_WIDTH = ATTN_WIDTH + POOL_WIDTH + CONV_WIDTH
IN_WIDTH = ATTN_WIDTH + 2 * KV_WIDTH + POOL_WIDTH + 3 * CONV_WIDTH
IN_SPLITS = (ATTN_WIDTH, ATTN_WIDTH + KV_WIDTH, ATTN_WIDTH + 2 * KV_WIDTH,
             ATTN_WIDTH + 2 * KV_WIDTH + POOL_WIDTH,
             ATTN_WIDTH + 2 * KV_WIDTH + POOL_WIDTH + CONV_WIDTH,
             ATTN_WIDTH + 2 * KV_WIDTH + POOL_WIDTH + 2 * CONV_WIDTH)

kernel_name = "hybrid_pool_conv_swa_diffusion_step"


def rms_norm(x, g):
    xf = x.astype(jnp.float32)
    y = xf * lax.rsqrt(jnp.mean(xf * xf, axis=-1, keepdims=True) + EPS)
    return (y * g.astype(jnp.float32)).astype(x.dtype)


def ada_params(cond, w_ada, b_ada):
    m = jax.nn.silu(cond) @ w_ada + b_ada
    return m.reshape(m.shape[:-1] + (N_MOD, D_MODEL))


def modulated_norm(x, mod, k, g):
    shift, scale = mod[:, None, 3 * k], mod[:, None, 3 * k + 1]
    return rms_norm(x, g) * (1 + scale) + shift


def ffn_sublayer(x, mod, k, g, w_in, w_out):
    h = modulated_norm(x, mod, k, g)
    gt, up = jnp.split(h @ w_in, 2, axis=-1)
    return x + 0.5 * mod[:, None, 3 * k + 2] * ((jax.nn.silu(gt) * up) @ w_out)


def multiscale_pool(u, pool_w, pool_scale):
    T = u.shape[1]
    uf = u.astype(jnp.float32)
    cs = jnp.concatenate([jnp.zeros_like(uf[:, :1]), jnp.cumsum(uf, axis=1)], axis=1)
    t = jnp.arange(T)
    outs = []
    for gi, w in enumerate(POOL_WINDOWS):
        lo = jnp.clip(t - w // 2, 0, T)
        hi = jnp.clip(t + w // 2, 0, T)
        sl = slice(gi * POOL_GROUP, (gi + 1) * POOL_GROUP)
        csg = cs[..., sl]
        cnt = (hi - lo).astype(jnp.float32)[None, :, None]
        pooled = (jnp.take(csg, hi, axis=1) - jnp.take(csg, lo, axis=1)) / cnt - uf[..., sl]
        outs.append(jnp.einsum('btc,cd->btd', pooled.astype(u.dtype), pool_w[gi]))
    return jnp.concatenate(outs, axis=-1) * pool_scale


def short_conv(u, bgate, cgate, conv_w):
    T = u.shape[1]
    zp = jnp.pad(cgate * u, ((0, 0), (1, 1), (0, 0)))
    conv = zp[:, 0:T] * conv_w[0] + zp[:, 1:T + 1] * conv_w[1] + zp[:, 2:T + 2] * conv_w[2]
    return bgate * conv


def axial_rope(x):
    T = x.shape[1]
    rows = T // GRID_W
    row = jnp.repeat(jnp.arange(rows), GRID_W).astype(jnp.float32)
    col = jnp.tile(jnp.arange(GRID_W), rows).astype(jnp.float32)
    half = HEAD_DIM // 2
    inv = ROPE_BASE ** (-jnp.arange(0, half, 2, dtype=jnp.float32) / half)

    def rot(xa, pos):
        ang = pos[:, None] * inv[None, :]
        cos = jnp.cos(ang)[None, :, None, :]
        sin = jnp.sin(ang)[None, :, None, :]
        x1, x2 = jnp.split(xa, 2, axis=-1)
        return jnp.concatenate([x1 * cos - x2 * sin, x1 * sin + x2 * cos], axis=-1)

    xf = x.astype(jnp.float32)
    out = jnp.concatenate([rot(xf[..., :half], row), rot(xf[..., half:], col)], axis=-1)
    return out.astype(x.dtype)


def context_attention(q, k, v, sink):
    Bn, T = q.shape[:2]
    qg = q.reshape(Bn, T, N_KV_HEADS, GQA_GROUP, HEAD_DIM)
    s = jnp.einsum('bqkgd,bskd->bkgqs', qg, k).astype(jnp.float32) * (HEAD_DIM ** -0.5)
    s_sink = jnp.broadcast_to(sink.astype(jnp.float32).reshape(1, N_KV_HEADS, GQA_GROUP, 1, 1), s.shape[:-1] + (1,))
    p = jax.nn.softmax(jnp.concatenate([s, s_sink], axis=-1), axis=-1).astype(v.dtype)
    o = jnp.einsum('bkgqs,bskd->bqkgd', p[..., :T], v)
    return o.reshape(Bn, T, ATTN_WIDTH)


def windowed_attention(q, k, v, ck, cv, sink):
    Bn, T = q.shape[:2]
    C = ck.shape[1]
    nb = T // BLOCK
    L = 3 * BLOCK
    qb = q.reshape(Bn, nb, BLOCK, N_KV_HEADS, GQA_GROUP, HEAD_DIM)

    def band(a):
        ap = jnp.pad(a, ((0, 0), (BLOCK, BLOCK), (0, 0), (0, 0))).reshape(Bn, nb + 2, BLOCK, N_KV_HEADS, HEAD_DIM)
        return jnp.concatenate([ap[:, :nb], ap[:, 1:nb + 1], ap[:, 2:]], axis=2)

    kb, vb = band(k), band(v)
    qi = jnp.arange(BLOCK)[:, None]
    sj = jnp.arange(L)[None, :]
    kpos = jnp.arange(nb)[:, None, None] * BLOCK - BLOCK + sj[None]
    valid = (jnp.abs(sj - BLOCK - qi) <= WINDOW)[None] & (kpos >= 0) & (kpos < T)
    scale = HEAD_DIM ** -0.5
    s_loc = jnp.einsum('bnqkgd,bnskd->bnkgqs', qb, kb).astype(jnp.float32) * scale
    s_loc = jnp.where(valid[None, :, None, None], s_loc, NEG)
    s_ctx = jnp.einsum('bnqkgd,bckd->bnkgqc', qb, ck).astype(jnp.float32) * scale
    s_sink = jnp.broadcast_to(sink.astype(jnp.float32).reshape(1, 1, N_KV_HEADS, GQA_GROUP, 1, 1), s_loc.shape[:-1] + (1,))
    p = jax.nn.softmax(jnp.concatenate([s_loc, s_ctx, s_sink], axis=-1), axis=-1).astype(v.dtype)
    o = (jnp.einsum('bnkgqs,bnskd->bnqkgd', p[..., :L], vb)
         + jnp.einsum('bnkgqc,bckd->bnqkgd', p[..., L:L + C], cv))
    return o.reshape(Bn, T, ATTN_WIDTH)


def trunk_layer(x, mod, norm_g, w_ffn_in, w_ffn_out, w_in, w_out, q_norm_g, k_norm_g, sink,
                pool_w, pool_scale, conv_w, ctx_k, ctx_v, latent):
    Bn, T, _ = x.shape
    x = ffn_sublayer(x, mod, 0, norm_g[0], w_ffn_in[0], w_ffn_out[0])
    h = modulated_norm(x, mod, 1, norm_g[1])
    q, k, v, u_pool, u_conv, bg, cg = jnp.split(h @ w_in, IN_SPLITS, axis=-1)
    q = rms_norm(q.reshape(Bn, T, N_HEADS, HEAD_DIM), q_norm_g)
    k = rms_norm(k.reshape(Bn, T, N_KV_HEADS, HEAD_DIM), k_norm_g)
    v = v.reshape(Bn, T, N_KV_HEADS, HEAD_DIM)
    if latent:
        attn = windowed_attention(axial_rope(q), axial_rope(k), v, ctx_k, ctx_v, sink)
    else:
        attn = context_attention(q, k, v, sink)
    pool = multiscale_pool(u_pool, pool_w, pool_scale)
    conv = short_conv(u_conv, bg, cg, conv_w)
    y = jnp.concatenate([attn, pool, conv], axis=-1) @ w_out
    x = x + mod[:, None, 5] * y
    x = ffn_sublayer(x, mod, 2, norm_g[2], w_ffn_in[1], w_ffn_out[1])
    return x, k, v


def setup_inputs(seed: int = 0) -> dict:
    key = jax.random.key(seed)
    ks = jax.random.split(key, 20)
    f32 = jnp.float32
    nrm = lambda k, s: jax.random.normal(k, s, f32)
    return {
        'x_prompt': nrm(ks[0], (BATCH, SEQ, D_MODEL)),
        'x_sample': nrm(ks[1], (DEC_BATCH, DEC_SEQ, D_MODEL)),
        'cache_k': nrm(ks[2], (DEC_BATCH, DEPTH, PAST_LEN, N_KV_HEADS, HEAD_DIM)),
        'cache_v': nrm(ks[3], (DEC_BATCH, DEPTH, PAST_LEN, N_KV_HEADS, HEAD_DIM)),
        'c': nrm(ks[4], (DEC_BATCH, D_MODEL)),
        'c_ctx': nrm(ks[5], (D_MODEL,)),
        'w_ada': nrm(ks[6], (DEPTH, D_MODEL, N_MOD * D_MODEL)) * (0.2 * D_MODEL ** -0.5),
        'b_ada': nrm(ks[7], (DEPTH, N_MOD * D_MODEL)) * 0.02,
        'norm_g': 1.0 + 0.02 * nrm(ks[8], (DEPTH, 3, D_MODEL)),
        'w_ffn_in': nrm(ks[9], (DEPTH, 2, D_MODEL, 2 * D_FF)) * D_MODEL ** -0.5,
        'w_ffn_out': nrm(ks[10], (DEPTH, 2, D_FF, D_MODEL)) * D_FF ** -0.5,
        'w_in': nrm(ks[11], (DEPTH, D_MODEL, IN_WIDTH)) * D_MODEL ** -0.5,
        'w_out': nrm(ks[12], (DEPTH, MIX_WIDTH, D_MODEL)) * MIX_WIDTH ** -0.5,
        'q_norm_g': 1.0 + 0.02 * nrm(ks[13], (DEPTH, HEAD_DIM)),
        'k_norm_g': 1.0 + 0.02 * nrm(ks[14], (DEPTH, HEAD_DIM)),
        'sink': 0.5 * nrm(ks[15], (DEPTH, N_HEADS)),
        'pool_w': nrm(ks[16], (DEPTH, len(POOL_WINDOWS), POOL_GROUP, POOL_GROUP)) * POOL_GROUP ** -0.5,
        'pool_scale': 1.0 + 0.02 * nrm(ks[17], (DEPTH, POOL_WIDTH)),
        'conv_w': nrm(ks[18], (DEPTH, CONV_K, CONV_WIDTH)) * CONV_K ** -0.5,
    }


def reference(x_prompt, x_sample, cache_k, cache_v, c, c_ctx, w_ada, b_ada, norm_g, w_ffn_in, w_ffn_out,
              w_in, w_out, q_norm_g, k_norm_g, sink, pool_w, pool_scale, conv_w):
    xp, xs = x_prompt, x_sample
    new_k, new_v = [], []
    for l in range(DEPTH):
        mod_ctx = ada_params(c_ctx[None, :], w_ada[l], b_ada[l])
        mod_lat = ada_params(c, w_ada[l], b_ada[l])
        xp, kl, vl = trunk_layer(xp, mod_ctx, norm_g[l], w_ffn_in[l], w_ffn_out[l], w_in[l], w_out[l],
                                 q_norm_g[l], k_norm_g[l], sink[l], pool_w[l], pool_scale[l], conv_w[l],
                                 None, None, False)
        new_k.append(kl)
        new_v.append(vl)
        xs, _, _ = trunk_layer(xs, mod_lat, norm_g[l], w_ffn_in[l], w_ffn_out[l], w_in[l], w_out[l],
                               q_norm_g[l], k_norm_g[l], sink[l], pool_w[l], pool_scale[l], conv_w[l],
                               cache_k[:, l], cache_v[:, l], True)
    state_k = jnp.stack(new_k, axis=1)
    state_v = jnp.stack(new_v, axis=1)
    return (xp, xs, state_k, state_v)
```

```cpp
#include <hip/hip_runtime.h>
#include <hip/hip_cooperative_groups.h>
#include <hip/hip_bf16.h>
#include <cstdio>
#include <cstdint>
#include <cmath>
namespace cg = cooperative_groups;
namespace pg8 {
#define PG8_LAS __attribute__((address_space(3)))
typedef unsigned short bf16_t;
typedef short bf16x8 __attribute__((ext_vector_type(8)));
typedef float f32x4 __attribute__((ext_vector_type(4)));
typedef unsigned u32x4 __attribute__((ext_vector_type(4)));
constexpr int BM = 256, BK = 64, HALF = 128, HTB = HALF * BK * 2  , STAGE_BYTES = 8 * HTB, NXCD = 8, WGM = 8;

__host__ __device__ __forceinline__ int lds_byte(int r, int c) { const int st = (r >> 4) * 2 + (c >> 5), rr = r & 15, cc = c & 31, ob = rr * 64 + cc * 2; return st * 1024 + (ob ^ (((ob >> 9) & 1) << 5)); }
__host__ __device__ __forceinline__ void stage_rc(int b, int& R, int& C) { const int st = b / 1024, sb = b % 1024, swz = sb ^ (((sb >> 9) & 1) << 5); R = (st >> 1) * 16 + swz / 64; C = (st & 1) * 32 + (swz % 64) / 2; }
__host__ __device__ __forceinline__ int perm32(int rho) { const int n = rho >> 4, i = rho & 15; return 8 * (i >> 2) + 4 * n + (i & 3); }

struct Unit { int pm, pn; };
struct Gemm { const bf16_t* A; const bf16_t* Bt; int M, N, K; };

struct StaticOrder {
    int nM, nN, nwg, G, c;
    __host__ __device__ void init(int M, int N, int G_, int c_) { nM = M / BM; nN = N / BM; nwg = nM * nN; G = G_; c = c_; }
    __host__ __device__ bool next(int i, Unit& u) const {
        const long L = (long)i * G + c; if (L >= nwg) return false;
        int wgid = (int)L; { const int q = nwg / NXCD, r = nwg % NXCD, xcd = wgid % NXCD, off = wgid / NXCD; wgid = (xcd < r ? xcd * (q + 1) : r * (q + 1) + (xcd - r) * q) + off; }
        const int nig = WGM * nN, gid = wgid / nig, fm = gid * WGM, gsz = (nM - fm) < WGM ? (nM - fm) : WGM;
        u.pm = fm + ((wgid % nig) % gsz); u.pn = (wgid % nig) / gsz; return true;
    }
    __device__ __forceinline__ void a_ready(const Unit&) const {}
    __device__ __forceinline__ void done(const Unit&) const {}
};

__device__ __forceinline__ unsigned cvt_pk_bf16(float lo, float hi) { unsigned r; asm volatile("v_cvt_pk_bf16_f32 %0, %1, %2" : "=v"(r) : "v"(lo), "v"(hi)); return r; }
typedef float f32x2 __attribute__((ext_vector_type(2)));
template <class Epi, class Sched, bool ALIGN_EPI = false, bool SP2 = false>
__device__ __forceinline__ void gemm_phase(PG8_LAS unsigned char* lds, const Gemm g, const Sched& S, const Epi& E) {
    int tid_ = threadIdx.x; asm volatile("" : "+v"(tid_));
    const int tid = tid_, wid = __builtin_amdgcn_readfirstlane(tid >> 6), lane = tid & 63, wr = wid >> 2, wc = wid & 3, fr = lane & 15, fq = lane >> 4;
    const int K = g.K, nt = K / BK;
    unsigned voffA[2], voffB[2];
#pragma unroll
    for (int i = 0; i < 2; ++i) { int R, C; stage_rc(tid * 16 + i * 8192, R, C); const int Rb = Epi::PERM ? ((R & ~31) + perm32(R & 31)) : R;
        voffA[i] = (unsigned)(R * K + C) * 2u; voffB[i] = (unsigned)(Rb * K + C) * 2u; }
    const size_t kstep = (size_t)(BK * 2);
    const size_t hstep = (size_t)HALF * K * 2;
    const size_t tstep = 2 * hstep;
    const unsigned ldsw = (unsigned)wid * 1024u;
    const int aoff = lds_byte(wr * 64 + fr, fq * 8), boff = lds_byte(wc * 32 + fr, fq * 8);
#define PG8_SA(b, h) (((b) * 2 + (h)) * HTB)
#define PG8_SB(b, h) ((4 + (b) * 2 + (h)) * HTB)
#define PG8_STAGE(bufoff, gbase, voff) do { _Pragma("unroll") for (int _i = 0; _i < 2; ++_i) \
        __builtin_amdgcn_global_load_lds((const unsigned*)((const char*)(gbase) + (voff)[_i]), (PG8_LAS unsigned*)(lds + (bufoff) + ldsw + _i * 8192), 16, 0, 0); } while (0)
#define PG8_LDA(dst, b, h) do { _Pragma("unroll") for (int m = 0; m < 4; ++m) _Pragma("unroll") for (int k = 0; k < 2; ++k) dst[m][k] = *(const PG8_LAS bf16x8*)(lds + PG8_SA(b, h) + aoff + m * 2048 + k * 1024); } while (0)
#define PG8_LDB(dst, b, h) do { _Pragma("unroll") for (int n = 0; n < 2; ++n) _Pragma("unroll") for (int k = 0; k < 2; ++k) dst[n][k] = *(const PG8_LAS bf16x8*)(lds + PG8_SB(b, h) + boff + n * 2048 + k * 1024); } while (0)
#define PG8_MMA(ai, bj, At, Bt) do { __builtin_amdgcn_s_setprio(1); _Pragma("unroll") for (int m = 0; m < 4; ++m) _Pragma("unroll") for (int n = 0; n < 2; ++n) _Pragma("unroll") for (int k = 0; k < 2; ++k) \
        acc[ai][bj][m][n] = __builtin_amdgcn_mfma_f32_16x16x32_bf16(Bt[n][k], At[m][k], acc[ai][bj][m][n], 0, 0, 0); __builtin_amdgcn_s_setprio(0); } while (0)
#define PG8_WAIT_V(n) asm volatile("s_waitcnt vmcnt(" #n ")" ::: "memory")
#define PG8_WAIT_L(n) asm volatile("s_waitcnt lgkmcnt(" #n ")" ::: "memory")
#define PG8_BAR __builtin_amdgcn_s_barrier()
#define PG8_SCHED __builtin_amdgcn_sched_barrier(0)
    Unit cur, nxt; int ui = 0;
    if (!S.next(0, cur)) return;
    f32x4 acc[2][2][4][2];
#pragma unroll
    for (int a = 0; a < 2; ++a)
#pragma unroll
        for (int b = 0; b < 2; ++b)
#pragma unroll
            for (int m = 0; m < 4; ++m)
#pragma unroll
                for (int n = 0; n < 2; ++n) acc[a][b][m][n] = (f32x4){0.f, 0.f, 0.f, 0.f};
    bf16x8 At[4][2], B0[2][2], B1[2][2];
    const char* cA = (const char*)g.A + (size_t)cur.pm * tstep; const char* cB = (const char*)g.Bt + (size_t)cur.pn * tstep;
    S.a_ready(cur);
    if constexpr (SP2) {
        PG8_STAGE(PG8_SB(0, 0), cB, voffB); PG8_STAGE(PG8_SB(0, 1), cB + hstep, voffB); PG8_STAGE(PG8_SA(0, 0), cA, voffA); PG8_STAGE(PG8_SA(0, 1), cA + hstep, voffA);
        if (wr == 1) PG8_BAR;
        PG8_WAIT_V(2); PG8_BAR;
        PG8_STAGE(PG8_SB(1, 0), cB + kstep, voffB); PG8_STAGE(PG8_SA(1, 0), cA + kstep, voffA); PG8_STAGE(PG8_SB(1, 1), cB + hstep + kstep, voffB);
        PG8_WAIT_V(6); PG8_BAR;
    } else {
        PG8_STAGE(PG8_SB(0, 0), cB, voffB); PG8_STAGE(PG8_SA(0, 0), cA, voffA); PG8_STAGE(PG8_SB(0, 1), cB + hstep, voffB); PG8_STAGE(PG8_SA(0, 1), cA + hstep, voffA);
        if (wr == 1) PG8_BAR;
        PG8_WAIT_V(4); PG8_BAR;
        PG8_STAGE(PG8_SB(1, 0), cB + kstep, voffB); PG8_STAGE(PG8_SA(1, 0), cA + kstep, voffA); PG8_STAGE(PG8_SB(1, 1), cB + hstep + kstep, voffB);
        PG8_WAIT_V(6); PG8_BAR;
    }
    for (;;) {
        const bool has_next = S.next(ui + 1, nxt);
        const char* nA = has_next ? (const char*)g.A + (size_t)nxt.pm * tstep : cA; const char* nB = has_next ? (const char*)g.Bt + (size_t)nxt.pn * tstep : cB;
        for (int t = 0; t < nt; t += 2) {
            const bool last = (t == nt - 2);
            const char* a1 = cA + (size_t)(t + 1) * kstep;
            const char* a2 = last ? nA : cA + (size_t)(t + 2) * kstep; const char* b2 = last ? nB : cB + (size_t)(t + 2) * kstep;
            const char* a3 = a2 + kstep; const char* b3 = b2 + kstep;
            if (last && has_next) S.a_ready(nxt);
            if constexpr (SP2) {
            PG8_LDB(B0, 0, 0); PG8_LDB(B1, 0, 1); PG8_SCHED; PG8_LDA(At, 0, 0); PG8_STAGE(PG8_SA(1, 1), a1 + hstep, voffA);
            PG8_WAIT_V(8); PG8_WAIT_L(0); PG8_BAR; PG8_MMA(0, 0, At, B0); PG8_MMA(0, 1, At, B1); PG8_BAR; PG8_SCHED;
            PG8_LDA(At, 0, 1); PG8_STAGE(PG8_SB(0, 0), b2, voffB); PG8_STAGE(PG8_SB(0, 1), b2 + hstep, voffB); PG8_STAGE(PG8_SA(0, 0), a2, voffA);
            PG8_WAIT_V(8); PG8_WAIT_L(0); PG8_BAR; PG8_MMA(1, 0, At, B0); PG8_MMA(1, 1, At, B1); PG8_BAR; PG8_SCHED;
            PG8_LDB(B0, 1, 0); PG8_LDB(B1, 1, 1); PG8_SCHED; PG8_LDA(At, 1, 0); PG8_STAGE(PG8_SA(0, 1), a2 + hstep, voffA);
            PG8_WAIT_V(8); PG8_WAIT_L(0); PG8_BAR; PG8_MMA(0, 0, At, B0); PG8_MMA(0, 1, At, B1); PG8_BAR; PG8_SCHED;
            PG8_LDA(At, 1, 1); PG8_STAGE(PG8_SB(1, 0), b3, voffB); PG8_STAGE(PG8_SB(1, 1), b3 + hstep, voffB); PG8_STAGE(PG8_SA(1, 0), a3, voffA);
            PG8_WAIT_V(8); PG8_WAIT_L(0); PG8_BAR; PG8_MMA(1, 0, At, B0); PG8_MMA(1, 1, At, B1); PG8_BAR; PG8_SCHED;
            } else {
            PG8_LDB(B0, 0, 0); PG8_SCHED; PG8_LDA(At, 0, 0); PG8_STAGE(PG8_SA(1, 1), a1 + hstep, voffA);
            PG8_WAIT_L(8); PG8_BAR; PG8_WAIT_L(0); PG8_MMA(0, 0, At, B0); PG8_BAR; PG8_SCHED;
            PG8_LDB(B1, 0, 1); PG8_STAGE(PG8_SB(0, 0), b2, voffB);
            PG8_BAR; PG8_WAIT_L(0); PG8_MMA(0, 1, At, B1); PG8_BAR;
            PG8_LDA(At, 0, 1); PG8_STAGE(PG8_SA(0, 0), a2, voffA);
            PG8_BAR; PG8_WAIT_L(0); PG8_MMA(1, 0, At, B0); PG8_BAR; PG8_SCHED;
            PG8_STAGE(PG8_SB(0, 1), b2 + hstep, voffB);
            PG8_WAIT_V(6); PG8_BAR; PG8_MMA(1, 1, At, B1); PG8_BAR;
            PG8_LDB(B0, 1, 0); PG8_SCHED; PG8_LDA(At, 1, 0); PG8_STAGE(PG8_SA(0, 1), a2 + hstep, voffA);
            PG8_WAIT_L(8); PG8_BAR; PG8_WAIT_L(0); PG8_MMA(0, 0, At, B0); PG8_BAR; PG8_SCHED;
            PG8_LDB(B1, 1, 1); PG8_STAGE(PG8_SB(1, 0), b3, voffB);
            PG8_BAR; PG8_WAIT_L(0); PG8_MMA(0, 1, At, B1); PG8_BAR;
            PG8_LDA(At, 1, 1); PG8_STAGE(PG8_SA(1, 0), a3, voffA);
            PG8_BAR; PG8_WAIT_L(0); PG8_MMA(1, 0, At, B0); PG8_BAR; PG8_SCHED;
            PG8_STAGE(PG8_SB(1, 1), b3 + hstep, voffB);
            PG8_WAIT_V(6); PG8_BAR; PG8_MMA(1, 1, At, B1); PG8_BAR;
            }
        }
        if constexpr (ALIGN_EPI) { if (wr == 0) PG8_BAR; }
        if constexpr (!Epi::AFTER_DRAIN) { E(acc, cur, wr, wc, fr, fq); S.done(cur); }
        if (!has_next) break;
#pragma unroll
        for (int a = 0; a < 2; ++a)
#pragma unroll
            for (int b = 0; b < 2; ++b)
#pragma unroll
                for (int m = 0; m < 4; ++m)
#pragma unroll
                    for (int n = 0; n < 2; ++n) acc[a][b][m][n] = (f32x4){0.f, 0.f, 0.f, 0.f};
        cur = nxt; cA = nA; cB = nB; ++ui;
        if constexpr (ALIGN_EPI) { if (wr == 1) PG8_BAR; }
    }
    PG8_WAIT_V(0);
    if constexpr (!ALIGN_EPI) { if (wr == 0) PG8_BAR; }
    PG8_BAR;
    if constexpr (Epi::AFTER_DRAIN) { E.fused(acc, cur, wr, wc, fr, fq, lds, wid, lane); S.done(cur); }
#undef PG8_SA
#undef PG8_SB
#undef PG8_STAGE
#undef PG8_LDA
#undef PG8_LDB
#undef PG8_MMA
#undef PG8_WAIT_V
#undef PG8_WAIT_L
#undef PG8_BAR
#undef PG8_SCHED
}
}
namespace pg8 {
typedef unsigned u32x2 __attribute__((ext_vector_type(2)));
__device__ __forceinline__ float silu_f(float g) { return g * __builtin_amdgcn_rcpf(1.0f + __builtin_amdgcn_exp2f(-1.4426950408889634f * g)); }
struct EpiSwiGLU {
    static constexpr bool PERM = true, AFTER_DRAIN = false;
    bf16_t* H;
    __device__ __forceinline__ void operator()(const f32x4 (&acc)[2][2][4][2], const Unit& u, int wr, int wc, int fr, int fq) const {
        asm volatile("" : "+v"(fr), "+v"(fq));
        const int row0 = u.pm * BM + wr * 64 + fr, col0 = u.pn * 128 + wc * 32 + 8 * fq;
#pragma unroll
        for (int ai = 0; ai < 2; ++ai)
#pragma unroll
            for (int m = 0; m < 4; ++m) {
                bf16_t* rowp = H + (size_t)(row0 + ai * HALF + m * 16) * 2816 + col0;
                const f32x4 g0 = acc[ai][0][m][0], g1 = acc[ai][0][m][1], u0 = acc[ai][1][m][0], u1 = acc[ai][1][m][1];
                u32x4 w;
                w.x = cvt_pk_bf16(silu_f(g0[0]) * u0[0], silu_f(g0[1]) * u0[1]); w.y = cvt_pk_bf16(silu_f(g0[2]) * u0[2], silu_f(g0[3]) * u0[3]);
                w.z = cvt_pk_bf16(silu_f(g1[0]) * u1[0], silu_f(g1[1]) * u1[1]); w.w = cvt_pk_bf16(silu_f(g1[2]) * u1[2], silu_f(g1[3]) * u1[3]);
                *(u32x4*)rowp = w;
            }
    }
};
struct EpiResid {
    static constexpr bool PERM = false, AFTER_DRAIN = false;
    const float* xc; const float* xl; float* out; const float* gate_l; float gs;
    __device__ __forceinline__ void operator()(const f32x4 (&acc)[2][2][4][2], const Unit& u, int wr, int wc, int fr, int fq) const {
        asm volatile("" : "+v"(fr), "+v"(fq));
        const int cidx = u.pm < 16 ? 8 : ((u.pm - 16) >> 4);
        const float* gate = gate_l + (size_t)cidx * 9 * 1024;
        const int col0 = u.pn * BM + wc * 32 + 4 * fq;
        const float* xin = u.pm < 16 ? xc + (size_t)(u.pm * BM) * 1024 : xl + (size_t)(u.pm * BM - 4096) * 1024;
        float* xo = out + (size_t)(u.pm * BM) * 1024;
        f32x4 gv[2][2];
#pragma unroll
        for (int bj = 0; bj < 2; ++bj)
#pragma unroll
            for (int n = 0; n < 2; ++n) gv[bj][n] = *(const f32x4*)(gate + col0 + bj * HALF + n * 16) * gs;
#pragma unroll
        for (int ai = 0; ai < 2; ++ai)
#pragma unroll
            for (int m = 0; m < 4; ++m) {
                const size_t off = (size_t)(ai * HALF + wr * 64 + m * 16 + fr) * 1024 + col0;
#pragma unroll
                for (int bj = 0; bj < 2; ++bj)
#pragma unroll
                    for (int n = 0; n < 2; ++n) {
                        const f32x4 xv = *(const f32x4*)(xin + off + bj * HALF + n * 16);
                        *(f32x4*)(xo + off + bj * HALF + n * 16) = xv + gv[bj][n] * acc[ai][bj][m][n];
                    }
                if (m & 1) asm volatile("" ::: "memory");
            }
    }
};
struct EpiIn {
    static constexpr bool PERM = true, AFTER_DRAIN = false;
    bf16_t *Q, *K, *V, *U4; float* newk; float* newv; const float *qg, *kg; const float *ropeC, *ropeS;
    __device__ __forceinline__ void operator()(const f32x4 (&acc)[2][2][4][2], const Unit& u, int wr, int wc, int fr, int fq) const {
        asm volatile("" : "+v"(fr), "+v"(fq));
        const int pm = u.pm, pn = u.pn;
        if (pn >= 3) {
#pragma unroll
            for (int ai = 0; ai < 2; ++ai)
#pragma unroll
                for (int m = 0; m < 4; ++m) {
                    bf16_t* rowp = U4 + (size_t)(pm * BM + ai * HALF + wr * 64 + m * 16 + fr) * 1024 + (pn - 3) * 256 + wc * 32 + 8 * fq;
#pragma unroll
                    for (int bj = 0; bj < 2; ++bj) { const f32x4 v0 = acc[ai][bj][m][0], v1 = acc[ai][bj][m][1];
                        u32x4 w; w.x = cvt_pk_bf16(v0[0], v0[1]); w.y = cvt_pk_bf16(v0[2], v0[3]); w.z = cvt_pk_bf16(v1[0], v1[1]); w.w = cvt_pk_bf16(v1[2], v1[3]);
                        *(u32x4*)(rowp + bj * HALF) = w; }
                }
            return;
        }
        const bool latent = pm >= 16, isq = pn < 2, isv = (!isq) && wc >= 2;
        const float* g = isq ? qg : kg;
        const f32x4 g0 = *(const f32x4*)(g + 4 * fq), g1 = *(const f32x4*)(g + 16 + 4 * fq), g2 = *(const f32x4*)(g + 32 + 4 * fq), g3 = *(const f32x4*)(g + 48 + 4 * fq);
        const float C2 = 0.125f * 1.4426950408889634f;
#pragma unroll
        for (int ai = 0; ai < 2; ++ai)
#pragma unroll
            for (int m = 0; m < 4; ++m) {
                const int s = ai * HALF + wr * 64 + m * 16 + fr; const size_t row = (size_t)pm * BM + s;
                f32x4 a0 = acc[ai][0][m][0], a1 = acc[ai][0][m][1], b0 = acc[ai][1][m][0], b1 = acc[ai][1][m][1];
                if (!isv) {
                    float ss = (a0[0] * a0[0] + a0[1] * a0[1]) + (a0[2] * a0[2] + a0[3] * a0[3]) + (a1[0] * a1[0] + a1[1] * a1[1]) + (a1[2] * a1[2] + a1[3] * a1[3])
                             + (b0[0] * b0[0] + b0[1] * b0[1]) + (b0[2] * b0[2] + b0[3] * b0[3]) + (b1[0] * b1[0] + b1[1] * b1[1]) + (b1[2] * b1[2] + b1[3] * b1[3]);
                    ss += __shfl_xor(ss, 16); ss += __shfl_xor(ss, 32);
                    const float rinv = 1.0f / sqrtf(ss * (1.0f / 64.0f) + 1e-6f);
                    a0 = a0 * rinv * g0; a1 = a1 * rinv * g1; b0 = b0 * rinv * g2; b1 = b1 * rinv * g3;
                    if (!latent && !isq) {
                        float* o = newk + ((size_t)(pm * 2) * 256 + s) * 128 + (wc & 1) * 64 + 4 * fq;
                        *(f32x4*)o = a0; *(f32x4*)(o + 16) = a1; *(f32x4*)(o + 32) = b0; *(f32x4*)(o + 48) = b1;
                    }
                    if (latent) {
                        const int rowpos = 4 * ((pm - 16) & 15) + 2 * ai + wr, colpos = 16 * m + fr;
                        const f32x4 cr = *(const f32x4*)(ropeC + rowpos * 16 + 4 * fq), sr = *(const f32x4*)(ropeS + rowpos * 16 + 4 * fq);
                        const f32x4 cc = *(const f32x4*)(ropeC + colpos * 16 + 4 * fq), sc = *(const f32x4*)(ropeS + colpos * 16 + 4 * fq);
                        const f32x4 t0 = a0 * cr - a1 * sr, t1 = a0 * sr + a1 * cr, t2 = b0 * cc - b1 * sc, t3 = b0 * sc + b1 * cc;
                        a0 = t0; a1 = t1; b0 = t2; b1 = t3;
                    }
                } else if (!latent) {
                    float* o = newv + ((size_t)(pm * 2) * 256 + s) * 128 + (wc & 1) * 64 + 4 * fq;
                    *(f32x4*)o = a0; *(f32x4*)(o + 16) = a1; *(f32x4*)(o + 32) = b0; *(f32x4*)(o + 48) = b1;
                }
                bf16_t* dst;
                if (isq) { a0 = a0 * C2; a1 = a1 * C2; b0 = b0 * C2; b1 = b1 * C2; dst = Q + row * 512 + (pn * 4 + wc) * 64 + 4 * fq; }
                else dst = (isv ? V : K) + row * 128 + (wc & 1) * 64 + 4 * fq;
                u32x2 w0, w1, w2, w3;
                w0.x = cvt_pk_bf16(a0[0], a0[1]); w0.y = cvt_pk_bf16(a0[2], a0[3]); w1.x = cvt_pk_bf16(a1[0], a1[1]); w1.y = cvt_pk_bf16(a1[2], a1[3]);
                w2.x = cvt_pk_bf16(b0[0], b0[1]); w2.y = cvt_pk_bf16(b0[2], b0[3]); w3.x = cvt_pk_bf16(b1[0], b1[1]); w3.y = cvt_pk_bf16(b1[2], b1[3]);
                *(u32x2*)dst = w0; *(u32x2*)(dst + 16) = w1; *(u32x2*)(dst + 32) = w2; *(u32x2*)(dst + 48) = w3;
                asm volatile("" ::: "memory");
            }
    }
};
}
namespace attn_body {
using bf16=__hip_bfloat16;
using bf16x8=__attribute__((ext_vector_type(8)))short;
using s16x4=__attribute__((ext_vector_type(4)))short;
using f32x16=__attribute__((ext_vector_type(16)))float;
using u32x4=__attribute__((ext_vector_type(4)))unsigned;
constexpr int D=64,QP=512,KP=128,OP=1024;
constexpr int NW=8,QBLK=32,QB=QBLK*NW,KVBLK=64;
constexpr int ATTN_UNIT_ROWS=QB;
__device__ __forceinline__ int crow(int r,int hi){return (r&3)+8*(r>>2)+4*hi;}
#define SBAR() __builtin_amdgcn_sched_barrier(0)
__device__ __forceinline__ void bmask(f32x16&p0,f32x16&p1,int dlt){
  const float NEG=-INFINITY;
  #pragma unroll
  for(int r=0;r<16;++r){int kv=dlt+(r&3)+8*(r>>2); if(kv>128||kv<-128)p0[r]=NEG; if(kv+32>128||kv+32<-128)p1[r]=NEG;}
}

constexpr int NSLOT=3, SLOTB=8192;
constexpr int LDS_K=0, LDS_V=NSLOT*SLOTB, LDS_WS=2*NSLOT*SLOTB, LDS_OST=LDS_WS+NW*64*4, LDS_BYTES=LDS_OST+NW*4096;
constexpr float C2=0.125f*1.4426950408889634f;
__device__ __forceinline__ void glds16(const void*gsrc,unsigned lds_dst){unsigned keep;
  asm volatile("s_mov_b32 %0, m0\n\ts_mov_b32 m0, %2\n\ts_nop 0\n\tglobal_load_lds_dwordx4 %1, off\n\ts_mov_b32 m0, %0":"=&s"(keep):"v"(gsrc),"s"(lds_dst):"memory");}
__device__ __forceinline__ float max3f(float a,float b,float c){float r;asm("v_max3_f32 %0, %1, %2, %3":"=v"(r):"v"(a),"v"(b),"v"(c));return r;}
__device__ __forceinline__ float max2f(float a,float b){float r;asm("v_max_f32_e32 %0, %1, %2":"=v"(r):"v"(a),"v"(b));return r;}
__device__ __forceinline__ float fadd_s(float a,float b){float r;asm("v_add_f32_e32 %0, %1, %2":"=v"(r):"v"(a),"v"(b));return r;}
__device__ __forceinline__ float fsub_s(float a,float b){float r;asm("v_sub_f32_e32 %0, %1, %2":"=v"(r):"v"(a),"v"(b));return r;}
typedef float f32x2_t __attribute__((ext_vector_type(2))); typedef __bf16 bf16x2_t __attribute__((ext_vector_type(2)));
__device__ __forceinline__ unsigned cvtpk_s(float lo,float hi){f32x2_t v={lo,hi};bf16x2_t b=__builtin_convertvector(v,bf16x2_t);return __builtin_bit_cast(unsigned,b);}
#define WAIT_BAR(N) asm volatile("s_waitcnt vmcnt(" #N ") lgkmcnt(0)\n\ts_barrier":::"memory")

__device__ __forceinline__ void qkt(f32x16&p0,f32x16&p1,const char*Kslot,const bf16x8*qr,const f32x16&negm,int r32,int hi){
  const char*kb=Kslot+hi*1024+r32*16;
  #pragma unroll
  for(int d0=0;d0<4;++d0){
    const bf16x8 b0=*reinterpret_cast<const bf16x8*>(kb+d0*2048);
    const bf16x8 b1=*reinterpret_cast<const bf16x8*>(kb+d0*2048+512);
    if(d0==0){p0=__builtin_amdgcn_mfma_f32_32x32x16_bf16(b0,qr[0],negm,0,0,0);p1=__builtin_amdgcn_mfma_f32_32x32x16_bf16(b1,qr[0],negm,0,0,0);}
    else{p0=__builtin_amdgcn_mfma_f32_32x32x16_bf16(b0,qr[d0],p0,0,0,0);p1=__builtin_amdgcn_mfma_f32_32x32x16_bf16(b1,qr[d0],p1,0,0,0);}}
}
typedef __attribute__((address_space(3))) const char* lds_cptr;
typedef short v4i16_t __attribute__((ext_vector_type(4)));
__device__ __forceinline__ void kload8(bf16x8*kf,lds_cptr kp){
  kf[0]=*(const __attribute__((address_space(3))) bf16x8*)(kp);      kf[1]=*(const __attribute__((address_space(3))) bf16x8*)(kp+512);
  kf[2]=*(const __attribute__((address_space(3))) bf16x8*)(kp+2048); kf[3]=*(const __attribute__((address_space(3))) bf16x8*)(kp+2560);
  kf[4]=*(const __attribute__((address_space(3))) bf16x8*)(kp+4096); kf[5]=*(const __attribute__((address_space(3))) bf16x8*)(kp+4608);
  kf[6]=*(const __attribute__((address_space(3))) bf16x8*)(kp+6144); kf[7]=*(const __attribute__((address_space(3))) bf16x8*)(kp+6656);
}
__device__ __forceinline__ void kload2(bf16x8*kf,lds_cptr kp,int j){ kf[2*j]=*(const __attribute__((address_space(3))) bf16x8*)(kp+j*2048); kf[2*j+1]=*(const __attribute__((address_space(3))) bf16x8*)(kp+j*2048+512); }
__device__ __forceinline__ s16x4 vtr(lds_cptr p){ return __builtin_bit_cast(s16x4,__builtin_amdgcn_ds_read_tr16_b64_v4i16((__attribute__((address_space(3))) v4i16_t*)p)); }
__device__ __forceinline__ float rowmax(const f32x16&p0,const f32x16&p1){
  float a=max3f(p0[0],p0[1],p1[0]),b=max3f(p0[2],p0[3],p1[1]);a=max3f(a,p1[2],p1[3]);
  #pragma unroll
  for(int r=4;r<16;r+=4){a=max3f(a,p0[r],p0[r+1]);b=max3f(b,p0[r+2],p0[r+3]);a=max3f(a,p1[r],p1[r+1]);b=max3f(b,p1[r+2],p1[r+3]);}
  const float m=max2f(a,b);
  auto rr=__builtin_amdgcn_permlane32_swap(__float_as_uint(m),__float_as_uint(m),false,false);
  return max2f(__uint_as_float(rr[0]),__uint_as_float(rr[1]));
}
__device__ __forceinline__ void pv(f32x16*o,int vb,bf16x8 pa0,bf16x8 pa1,bf16x8 pa2,bf16x8 pa3){
  #pragma unroll
  for(int d0=0;d0<2;++d0){s16x4 lo[4],hi[4];
    #pragma unroll
    for(int ks=0;ks<4;++ks){
      asm volatile("ds_read_b64_tr_b16 %0,%1 offset:%c2":"=&v"(lo[ks]):"v"(vb),"i"(d0*4096+ks*1024):"memory");
      asm volatile("ds_read_b64_tr_b16 %0,%1 offset:%c2":"=&v"(hi[ks]):"v"(vb),"i"(d0*4096+ks*1024+512):"memory");}
    asm volatile("s_waitcnt lgkmcnt(0)":::"memory");SBAR();
    #define PK(k) (bf16x8){lo[k][0],lo[k][1],lo[k][2],lo[k][3],hi[k][0],hi[k][1],hi[k][2],hi[k][3]}
    o[d0]=__builtin_amdgcn_mfma_f32_32x32x16_bf16(pa0,PK(0),o[d0],0,0,0);
    o[d0]=__builtin_amdgcn_mfma_f32_32x32x16_bf16(pa1,PK(1),o[d0],0,0,0);
    o[d0]=__builtin_amdgcn_mfma_f32_32x32x16_bf16(pa2,PK(2),o[d0],0,0,0);
    o[d0]=__builtin_amdgcn_mfma_f32_32x32x16_bf16(pa3,PK(3),o[d0],0,0,0);
    #undef PK
  }
}

#ifndef ATTN_STORE16
#define ATTN_STORE16(p,v) (*(u32x4*)(p)=(v))
#endif
template<int THRL> __device__ __forceinline__ void attn_unit(const bf16*Q0,bf16*O0,const bf16*__restrict__ KA,const bf16*__restrict__ VA,const bf16*__restrict__ KB,const bf16*__restrict__ VB,const int NC,const int NT,const int krelB,const float sink2,char*shm){
  int tid_=threadIdx.x; asm volatile("":"+v"(tid_));
  const int tid=tid_,lane=tid&63,r32=lane&31,hi=lane>>5; const int wid=__builtin_amdgcn_readfirstlane(tid>>6);
  const bf16*Qw=Q0+(long)(wid*QBLK)*QP;
  const unsigned lds0=(unsigned)(uintptr_t)shm;
  float*wsf=(float*)(shm+LDS_WS)+wid*64;
  const int koff=lane*KP+wid*8; const bf16*ksrcA=KA+koff,*ksrcB=KB+koff;
  const int voff=(16*(wid&3)+(lane>>2))*KP+(wid>>2)*32+(lane&3)*8; const bf16*vsrcA=VA+voff,*vsrcB=VB+voff;
  const unsigned kdst=lds0+LDS_K+wid*1024, vdst=lds0+LDS_V+wid*1024;
  #define DMA_K(t,slot) glds16(((t)<NC?ksrcA+(long)(t)*(KVBLK*KP):ksrcB+(long)((t)-NC)*(KVBLK*KP)),(unsigned)__builtin_amdgcn_readfirstlane(kdst+(slot)))
  #define DMA_V(t,slot) glds16(((t)<NC?vsrcA+(long)(t)*(KVBLK*KP):vsrcB+(long)((t)-NC)*(KVBLK*KP)),(unsigned)__builtin_amdgcn_readfirstlane(vdst+(slot)))
  const int vb0=(int)(lds0+LDS_V)+((lane>>4)&1)*32+(lane&3)*8+(4*hi+((lane&15)>>2))*64;
  const char*Kbase=shm+LDS_K; bf16x8 kf[8];
  const lds_cptr shm3=(lds_cptr)shm; const lds_cptr kp0=shm3+LDS_K+hi*1024+r32*16; const lds_cptr vp0=shm3+LDS_V+((lane>>4)&1)*32+(lane&3)*8+(4*hi+((lane&15)>>2))*64;
  DMA_K(0,0);DMA_V(0,0);DMA_K(1,SLOTB);
  bf16x8 qr[4];
  #pragma unroll
  for(int d0=0;d0<4;++d0)qr[d0]=*reinterpret_cast<const bf16x8*>(&Qw[(long)r32*QP+d0*16+hi*8]);
  float mhat=0.f,l_reg=0.f;f32x16 o[2];o[0]=f32x16{};o[1]=f32x16{};f32x16 negm=f32x16{};asm volatile("":"+v"(negm));
  const int qrel=wid*QBLK+r32;
  #define CMASK(P0,P1,t) do{ if((t)>=NC){ const int k0_=krelB+64*((t)-NC); if(!(k0_+63-wid*QBLK<=128 && wid*QBLK+31-k0_<=128)) bmask(P0,P1,k0_+4*hi-qrel); } }while(0)
  bool resc=false;
  #define START(P0,P1) do{ const float rm=rowmax(P0,P1); resc=false; \
    { const float dl=rm; mhat=fadd_s(mhat,dl); \
      _Pragma("unroll") for(int r=0;r<16;++r){P0[r]=fsub_s(P0[r],dl);P1[r]=fsub_s(P1[r],dl);} \
      _Pragma("unroll") for(int r=0;r<16;++r)negm[r]=-mhat; asm volatile("":"+v"(negm)); } \
    _Pragma("unroll") for(int r=0;r<16;++r)P0[r]=__builtin_amdgcn_exp2f(P0[r]); }while(0)
  #define RESC() do{ if(resc){ asm volatile("s_waitcnt lgkmcnt(0)":::"memory"); \
      _Pragma("unroll") for(int d_=0;d_<2;++d_) _Pragma("unroll") for(int r=0;r<16;++r)o[d_][r]*=wsf[crow(r,hi)]; } }while(0)
  f32x16 pA0,pA1,pB0,pB1;
  int sl_prev=0,sl_cur=0,sl_next=SLOTB;
  #define ROT() do{sl_prev=sl_cur;sl_cur=sl_next;sl_next=(sl_next==(NSLOT-1)*SLOTB)?0:sl_next+SLOTB;}while(0)
  DMA_K(2,2*SLOTB);
  WAIT_BAR(3);
  qkt(pA0,pA1,Kbase,qr,negm,r32,hi);asm volatile("s_nop 15\n\ts_nop 7":"+v"(pA0),"+v"(pA1));CMASK(pA0,pA1,0);
  START(pA0,pA1);
  _Pragma("unroll") for(int r=0;r<16;++r)pA1[r]=__builtin_amdgcn_exp2f(pA1[r]);
  WAIT_BAR(0);
  DMA_K(3,0);DMA_V(1,SLOTB);
  ROT();
  kload8(kf,kp0+sl_cur);
  WAIT_BAR(2);
  s16x4 vlo[8],vhi[8]; u32x4 pw0,pw1,pw2,pw3;
  #define PKW(P,B) cvtpk_s(P[B],P[B+1])
  #define PAF(k) __builtin_bit_cast(bf16x8,pw##k)
  #define VFR(i) (bf16x8){vlo[i][0],vlo[i][1],vlo[i][2],vlo[i][3],vhi[i][0],vhi[i][1],vhi[i][2],vhi[i][3]}
  #define PIN(x) asm volatile("":"+v"(x))
  #define MX3(a,b,c) __builtin_fmaxf(__builtin_fmaxf((a),(b)),(c))
  #define GAPA(MF,A0,A1,A2,A3,W0,W1,PW) do{ MF; sacc+=A0; sacc+=A1; sacc+=A2; sacc+=A3; PIN(sacc); W0; W1; PIN(PW); SBAR(); }while(0)
  #define EX(v) __builtin_amdgcn_exp2f(v)
  #define GAPB(MF,X,B) do{ MF; X[B]=EX(X[B]); X[B+1]=EX(X[B+1]); X[B+2]=EX(X[B+2]); X[B+3]=EX(X[B+3]); PIN(X); SBAR(); }while(0)
  #define VRD(i) do{ vlo[i]=vtr(vp_+(((i)>>2)*4096+((i)&3)*1024)); vhi[i]=vtr(vp_+(((i)>>2)*4096+((i)&3)*1024+512)); }while(0)
  #define KRD(G,j) do{ if(G){ kload2(kf,kp0+sl_next,j); SBAR(); } }while(0)
  #define STEP(C0,C1,P0,P1,t,GK,GV,GL) do{ SBAR(); \
    const lds_cptr vp_=vp0+sl_prev; \
    VRD(0); SBAR(); float sacc=(P0[0]+P0[1]); \
    GAPA(C0=__builtin_amdgcn_mfma_f32_32x32x16_bf16(kf[0],qr[0],negm,0,0,0), P0[2],P0[3],P0[4],P0[5],     pw0[0]=PKW(P0,0), pw0[1]=PKW(P0,2), pw0); \
    VRD(4); SBAR(); GAPA(C1=__builtin_amdgcn_mfma_f32_32x32x16_bf16(kf[1],qr[0],negm,0,0,0), P0[6],P0[7],P0[8],P0[9],     pw0[2]=PKW(P0,4), pw0[3]=PKW(P0,6), pw0); \
    VRD(1); SBAR(); GAPA(C0=__builtin_amdgcn_mfma_f32_32x32x16_bf16(kf[2],qr[1],C0,0,0,0),   P0[10],P0[11],P0[12],P0[13], pw1[0]=PKW(P0,8), pw1[1]=PKW(P0,10), pw1); \
    VRD(5); SBAR(); GAPA(C1=__builtin_amdgcn_mfma_f32_32x32x16_bf16(kf[3],qr[1],C1,0,0,0),   P0[14],P0[15],P1[0],P1[1],   pw1[2]=PKW(P0,12),pw1[3]=PKW(P0,14), pw1); \
    VRD(2); SBAR(); GAPA(C0=__builtin_amdgcn_mfma_f32_32x32x16_bf16(kf[4],qr[2],C0,0,0,0),   P1[2],P1[3],P1[4],P1[5],     pw2[0]=PKW(P1,0), pw2[1]=PKW(P1,2), pw2); \
    VRD(6); SBAR(); GAPA(C1=__builtin_amdgcn_mfma_f32_32x32x16_bf16(kf[5],qr[2],C1,0,0,0),   P1[6],P1[7],P1[8],P1[9],     pw2[2]=PKW(P1,4), pw2[3]=PKW(P1,6), pw2); \
    VRD(3); SBAR(); GAPA(C0=__builtin_amdgcn_mfma_f32_32x32x16_bf16(kf[6],qr[3],C0,0,0,0),   P1[10],P1[11],P1[12],P1[13], pw3[0]=PKW(P1,8), pw3[1]=PKW(P1,10), pw3); \
    VRD(7); SBAR(); GAPA(C1=__builtin_amdgcn_mfma_f32_32x32x16_bf16(kf[7],qr[3],C1,0,0,0),   P1[14],P1[15],0.f,0.f,       pw3[2]=PKW(P1,12),pw3[3]=PKW(P1,14), pw3); \
    l_reg+=sacc; \
    if(GK){DMA_K((t)+3,sl_cur);} if(GV){DMA_V((t)+1,sl_next);} \
    CMASK(C0,C1,t); \
    { float a=MX3(C0[0],C0[1],C1[0]),b=MX3(C0[2],C0[3],C1[1]); a=MX3(a,C1[2],C1[3]); \
      _Pragma("unroll") for(int r=4;r<16;r+=4){a=MX3(a,C0[r],C0[r+1]);b=MX3(b,C0[r+2],C0[r+3]);a=MX3(a,C1[r],C1[r+1]);b=MX3(b,C1[r+2],C1[r+3]);} \
      float rm=__builtin_fmaxf(a,b); { auto rr=__builtin_amdgcn_permlane32_swap(__float_as_uint(rm),__float_as_uint(rm),false,false); rm=__builtin_fmaxf(__uint_as_float(rr[0]),__uint_as_float(rr[1])); } \
      resc=false; \
      if(__builtin_expect(__any(rm>(float)THRL),0)){ const float dl=__builtin_fmaxf(rm,0.f); mhat+=dl; \
        _Pragma("unroll") for(int r=0;r<16;++r){C0[r]-=dl;C1[r]-=dl;} \
        _Pragma("unroll") for(int r=0;r<16;++r)negm[r]=-mhat; asm volatile("":"+v"(negm)); \
        const float f=__builtin_amdgcn_exp2f(-dl); l_reg*=f; if(hi==0)wsf[r32]=f; resc=true; } } \
    SBAR(); \
    GAPB(o[0]=__builtin_amdgcn_mfma_f32_32x32x16_bf16(PAF(0),VFR(0),o[0],0,0,0), C0,0); \
    GAPB(o[1]=__builtin_amdgcn_mfma_f32_32x32x16_bf16(PAF(0),VFR(4),o[1],0,0,0), C0,4); \
    KRD(GL,0); GAPB(o[0]=__builtin_amdgcn_mfma_f32_32x32x16_bf16(PAF(1),VFR(1),o[0],0,0,0), C0,8); \
    KRD(GL,1); GAPB(o[1]=__builtin_amdgcn_mfma_f32_32x32x16_bf16(PAF(1),VFR(5),o[1],0,0,0), C0,12); \
    KRD(GL,2); GAPB(o[0]=__builtin_amdgcn_mfma_f32_32x32x16_bf16(PAF(2),VFR(2),o[0],0,0,0), C1,0); \
    KRD(GL,3); GAPB(o[1]=__builtin_amdgcn_mfma_f32_32x32x16_bf16(PAF(2),VFR(6),o[1],0,0,0), C1,4); \
    GAPB(o[0]=__builtin_amdgcn_mfma_f32_32x32x16_bf16(PAF(3),VFR(3),o[0],0,0,0), C1,8); \
    GAPB(o[1]=__builtin_amdgcn_mfma_f32_32x32x16_bf16(PAF(3),VFR(7),o[1],0,0,0), C1,12); \
    }while(0)
  int t=1;
  #undef CMASK
  #define CMASK(P0,P1,t) do{}while(0)
  for(;t+5<NT&&t+2<=NC;t+=2){
    STEP(pB0,pB1,pA0,pA1,t,true,true,true);     WAIT_BAR(2); RESC(); ROT();
    STEP(pA0,pA1,pB0,pB1,t+1,true,true,true);   WAIT_BAR(2); RESC(); ROT();
  }
  #undef CMASK
  #define CMASK(P0,P1,t) do{ if((t)>=NC){ const int k0_=krelB+64*((t)-NC); if(!(k0_+63-wid*QBLK<=128 && wid*QBLK+31-k0_<=128)) bmask(P0,P1,k0_+4*hi-qrel); } }while(0)
  #define ENDW(tt) do{ if((tt)+3<NT){WAIT_BAR(2);} else if((tt)+2<NT){WAIT_BAR(1);} else {WAIT_BAR(0);} }while(0)
  for(;t+1<NT;t+=2){
    STEP(pB0,pB1,pA0,pA1,t,(t+3<NT),(t+1<NT),(t+1<NT));       ENDW(t);   RESC(); ROT();
    STEP(pA0,pA1,pB0,pB1,t+1,(t+4<NT),(t+2<NT),(t+2<NT));     ENDW(t+1); RESC(); ROT();
  }
  STEP(pB0,pB1,pA0,pA1,NT-1,false,false,false); RESC();
  { float sacc=pB0[0]+pB0[1]; _Pragma("unroll") for(int r=2;r<16;++r)sacc+=pB0[r]; _Pragma("unroll") for(int r=0;r<16;++r)sacc+=pB1[r]; l_reg+=sacc;
    pw0=(u32x4){PKW(pB0,0),PKW(pB0,2),PKW(pB0,4),PKW(pB0,6)};pw1=(u32x4){PKW(pB0,8),PKW(pB0,10),PKW(pB0,12),PKW(pB0,14)};pw2=(u32x4){PKW(pB1,0),PKW(pB1,2),PKW(pB1,4),PKW(pB1,6)};pw3=(u32x4){PKW(pB1,8),PKW(pB1,10),PKW(pB1,12),PKW(pB1,14)};
    SBAR(); pv(o,vb0+sl_cur,PAF(0),PAF(1),PAF(2),PAF(3)); }
  #undef PKW
  #undef PAF
  #undef VFR
  #undef PIN
  #undef MX3
  #undef GAPA
  #undef GAPB
  #undef EX
  #undef VRD
  #undef KRD
  #undef STEP
  #undef ENDW
  {auto rr=__builtin_amdgcn_permlane32_swap(__float_as_uint(l_reg),__float_as_uint(l_reg),false,false);l_reg=__uint_as_float(rr[0])+__uint_as_float(rr[1]);}
  l_reg+=__builtin_amdgcn_exp2f(sink2-mhat);
  if(hi==0)wsf[32+r32]=l_reg;asm volatile("s_waitcnt lgkmcnt(0)":::"memory");
  float rli[16];
  #pragma unroll
  for(int r=0;r<16;++r)rli[r]=__builtin_amdgcn_rcpf(wsf[32+crow(r,hi)]);
  bf16*Ow=O0+(long)(wid*QBLK)*OP;
  { bf16*stg=(bf16*)(shm+LDS_OST)+wid*2048;
    #pragma unroll
    for(int r=0;r<16;++r){const int orow=crow(r,hi);
      #pragma unroll
      for(int d0=0;d0<2;++d0)stg[orow*64+d0*32+r32]=__float2bfloat16(o[d0][r]*rli[r]);}
    asm volatile("s_waitcnt lgkmcnt(0)":::"memory");
    #pragma unroll
    for(int i=0;i<4;++i){const int row=i*8+(lane>>3),ch=lane&7; const u32x4 v=*(const u32x4*)(stg+row*64+ch*8); ATTN_STORE16(Ow+(long)row*OP+ch*8,v);} }
  asm volatile("s_waitcnt lgkmcnt(0)\n\ts_barrier":::"memory");
  #undef DMA_K
  #undef DMA_V
  #undef CMASK
  #undef START
  #undef RESC
  #undef ROT
}
constexpr int ATTN_LDS_BYTES=LDS_BYTES;
#undef SBAR
#undef WAIT_BAR
}
#define GAS __attribute__((address_space(1)))
#define LAS __attribute__((address_space(3)))
typedef unsigned short bf16;
typedef unsigned v4u __attribute__((ext_vector_type(4)));
typedef float f32x4 __attribute__((ext_vector_type(4)));
typedef short bf16x8 __attribute__((ext_vector_type(8)));
#define LDS_WAIT() asm volatile("s_waitcnt lgkmcnt(0)" ::: "memory")

constexpr int DM = 1024, MC = 4096, ML = 32768, MT = MC + ML, DFF = 2816, NIN = 1792, NWAVES = 8;
constexpr size_t MiB = 1u << 20;
constexpr size_t WS_MOD = 0;
constexpr size_t WS_ROPE = 1 * MiB;
constexpr size_t WS_WIN = 2 * MiB, WS_WOUT = 9 * MiB, WS_CK = 13 * MiB, WS_CV = 15 * MiB, WS_WFO = 17 * MiB, WS_WFI = 39 * MiB;
constexpr size_t WS_XN = 83 * MiB, WS_HID = 155 * MiB, WS_Q = 353 * MiB, WS_K = 389 * MiB, WS_V = 398 * MiB, WS_U4 = 407 * MiB, WS_END = 479 * MiB;
constexpr int LDS_BYTES = 147456;

__device__ __forceinline__ unsigned f2bf(float f) { unsigned u = __builtin_bit_cast(unsigned, f); return (u + 0x7fffu + ((u >> 16) & 1u)) >> 16; }
__device__ __forceinline__ unsigned pk2(float lo, float hi) { return f2bf(lo) | (f2bf(hi) << 16); }
__device__ __forceinline__ float bf2f(unsigned short b) { return __builtin_bit_cast(float, (unsigned)b << 16); }
__device__ __forceinline__ float wave_sum(float v) {
#pragma unroll
    for (int o = 1; o < 64; o <<= 1) v += __shfl_xor(v, o);
    return v;
}
__device__ __forceinline__ int rowmap(int mode, int n) {
    if (mode == 1) { const int up = n >= DFF; const int j = up ? n - DFF : n; return 256 * (j >> 7) + (up ? 128 : 0) + (j & 127); }
    if (mode == 2 && n < 768) { const int hd = n >> 6, d = n & 63; const int pn = hd >> 2, wc = hd & 3, bj = d >> 5, d2 = d & 31, nn = d2 >> 4, fq = (d2 & 15) >> 2, j = d2 & 3;
        return 256 * pn + 128 * bj + 32 * wc + 8 * fq + 4 * nn + j; }
    return n;
}
__device__ __forceinline__ void transpose_item(const float* W, int K, int N, bf16* WT, int mode, LAS float* scr, int item, int lane) {
    const int nblk = N / 32, kb = item / nblk, nb = item % nblk, k0 = 64 * kb, n0 = 32 * nb;
    if (mode == 3 && k0 >= 512 && k0 < 768) return;
#pragma unroll 8
    for (int i = 0; i < 32; ++i) { const int kk = 2 * i + (lane >> 5); scr[kk * 33 + (lane & 31)] = W[(size_t)(k0 + kk) * N + n0 + (lane & 31)]; }
    LDS_WAIT(); asm volatile("" ::: "memory");
    const int c = lane & 7;
#pragma unroll
    for (int j = 0; j < 4; ++j) { const int n = (lane >> 3) + 8 * j; const LAS float* s = scr + (8 * c) * 33 + n;
        v4u o; o.x = pk2(s[0 * 33], s[1 * 33]); o.y = pk2(s[2 * 33], s[3 * 33]); o.z = pk2(s[4 * 33], s[5 * 33]); o.w = pk2(s[6 * 33], s[7 * 33]);
        *(v4u*)(WT + (size_t)rowmap(mode, n0 + n) * K + k0 + 8 * c) = o; }
    LDS_WAIT(); asm volatile("" ::: "memory");
}
__device__ __forceinline__ void fold_item(const float* wout, const float* poolw, const float* pscale, bf16* WT, int item, int lane) {
    const int gi = item >> 5, ch = (item >> 4) & 1, n = (item & 15) * 64 + lane;
    const float* P = poolw + gi * 4096 + ch * 32 * 64;
    float a[32];
#pragma unroll
    for (int cc = 0; cc < 32; ++cc) a[cc] = 0.f;
#pragma unroll 1
    for (int d = 0; d < 64; ++d) {
        const float wv = wout[(size_t)(512 + 64 * gi + d) * 1024 + n] * pscale[64 * gi + d];
#pragma unroll
        for (int cc = 0; cc < 32; ++cc) a[cc] += P[cc * 64 + d] * wv;
    }
#pragma unroll
    for (int c0 = 0; c0 < 32; c0 += 8) {
        v4u o; o.x = pk2(a[c0], a[c0 + 1]); o.y = pk2(a[c0 + 2], a[c0 + 3]); o.z = pk2(a[c0 + 4], a[c0 + 5]); o.w = pk2(a[c0 + 6], a[c0 + 7]);
        *(v4u*)(WT + (size_t)n * 1024 + 512 + 64 * gi + ch * 32 + c0) = o;
    }
}

template <class T> __device__ __forceinline__ T* opq(T* p) { GAS T* g = (GAS T*)p; asm volatile("" : "+s"(g)); return (T*)g; }
struct Args { const float* in[19]; float* out; unsigned char* ws; };
typedef const __attribute__((address_space(4))) Args* KArgP;
__device__ __forceinline__ KArgP KARGS() { KArgP p = (KArgP)__builtin_amdgcn_kernarg_segment_ptr(); asm volatile("" : "+s"(p)); return p; }

__device__ __forceinline__ void norm_rows(const float* xc, const float* xl, bf16* XN, const float* mod_l, int k, const float* g, int gw, int NGW, int lane) {
    asm volatile("" : "+v"(lane));
    for (int row = gw; row < MT; row += NGW) {
        const int cidx = row < MC ? 8 : ((row - MC) >> 12);
        const float* xrow = row < MC ? xc + (size_t)row * DM : xl + (size_t)(row - MC) * DM;
        const float* sh = mod_l + (size_t)(cidx * 9 + 3 * k) * DM; const float* sc = sh + DM;
        f32x4 v[4]; float s = 0.f;
#pragma unroll
        for (int j = 0; j < 4; ++j) { v[j] = ((const f32x4*)xrow)[lane + 64 * j]; s += (v[j].x * v[j].x + v[j].y * v[j].y) + (v[j].z * v[j].z + v[j].w * v[j].w); }
        const float rstd = 1.0f / sqrtf(wave_sum(s) * (1.0f / DM) + 1e-6f);
        unsigned long long* o8 = (unsigned long long*)(XN + (size_t)row * DM) + lane;
#pragma unroll
        for (int j = 0; j < 4; ++j) {
            const f32x4 gv = ((const f32x4*)g)[lane + 64 * j], scv = ((const f32x4*)sc)[lane + 64 * j], shv = ((const f32x4*)sh)[lane + 64 * j];
            const f32x4 h = v[j] * rstd * gv * (scv + 1.0f) + shv;
            o8[64 * j] = (unsigned long long)pk2(h.x, h.y) | ((unsigned long long)pk2(h.z, h.w) << 32);
        }
    }
}

__device__ __forceinline__ void ld8(const bf16* p, float (&f)[8]) {
    const v4u w = *(const v4u*)p;
    f[0] = __builtin_bit_cast(float, w.x << 16); f[1] = __builtin_bit_cast(float, w.x & 0xffff0000u);
    f[2] = __builtin_bit_cast(float, w.y << 16); f[3] = __builtin_bit_cast(float, w.y & 0xffff0000u);
    f[4] = __builtin_bit_cast(float, w.z << 16); f[5] = __builtin_bit_cast(float, w.z & 0xffff0000u);
    f[6] = __builtin_bit_cast(float, w.w << 16); f[7] = __builtin_bit_cast(float, w.w & 0xffff0000u);
}
__device__ __forceinline__ void poolconv_rows(const bf16* U4, bf16* MIX, const float* convw, int blk, int G, int tid) {
    asm volatile("" : "+v"(tid));
    const int sub = tid >> 6, c64 = tid & 63;
    for (int r0 = blk * 8; r0 < MT; r0 += G * 8) {
        const int r = r0 + sub;
        const int s0 = r < MC ? (r & ~255) : MC + ((r - MC) & ~4095), T = r < MC ? 256 : 4096, t = r - s0;
        if (c64 < 32) {
            const int ch = 8 * c64, gi = ch >> 6, hw = 1 << gi;
            const int lo = t - hw < 0 ? 0 : t - hw, hi = t + hw > T ? T : t + hw;
            float acc[8] = {0.f, 0.f, 0.f, 0.f, 0.f, 0.f, 0.f, 0.f}, f[8];
            for (int j = lo; j < hi; ++j) { ld8(U4 + (size_t)(s0 + j) * 1024 + ch, f);
#pragma unroll
                for (int e = 0; e < 8; ++e) acc[e] += f[e]; }
            ld8(U4 + (size_t)r * 1024 + ch, f);
            const float inv = 1.0f / (float)(hi - lo);
            v4u o; o.x = pk2(acc[0] * inv - f[0], acc[1] * inv - f[1]); o.y = pk2(acc[2] * inv - f[2], acc[3] * inv - f[3]);
            o.z = pk2(acc[4] * inv - f[4], acc[5] * inv - f[5]); o.w = pk2(acc[6] * inv - f[6], acc[7] * inv - f[7]);
            *(v4u*)(MIX + (size_t)r * 1024 + 512 + ch) = o;
        } else {
            const int ch = 8 * (c64 - 32);
            float um[8], u0[8], up[8], cm[8], c0[8], cp[8], bg[8], y[8];
            const bf16* base = U4 + (size_t)r * 1024;
            ld8(base + 256 + ch, u0); ld8(base + 768 + ch, c0); ld8(base + 512 + ch, bg);
            if (t > 0) { ld8(base - 1024 + 256 + ch, um); ld8(base - 1024 + 768 + ch, cm); }
            if (t < T - 1) { ld8(base + 1024 + 256 + ch, up); ld8(base + 1024 + 768 + ch, cp); }
#pragma unroll
            for (int e = 0; e < 8; ++e) {
                const float zm = t > 0 ? um[e] * cm[e] : 0.f, zp = t < T - 1 ? up[e] * cp[e] : 0.f;
                y[e] = bg[e] * (zm * convw[ch + e] + u0[e] * c0[e] * convw[256 + ch + e] + zp * convw[512 + ch + e]);
            }
            v4u o; o.x = pk2(y[0], y[1]); o.y = pk2(y[2], y[3]); o.z = pk2(y[4], y[5]); o.w = pk2(y[6], y[7]);
            *(v4u*)(MIX + (size_t)r * 1024 + 768 + ch) = o;
        }
    }
}

#define ws ((unsigned char*)(GAS unsigned char*)(KARGS()->ws))
#define x_prompt ((const float*)(const GAS float*)(KARGS()->in[0]))
#define x_sample ((const float*)(const GAS float*)(KARGS()->in[1]))
#define cache_k ((const float*)(const GAS float*)(KARGS()->in[2]))
#define cache_v ((const float*)(const GAS float*)(KARGS()->in[3]))
#define cvec ((const float*)(const GAS float*)(KARGS()->in[4]))
#define c_ctx ((const float*)(const GAS float*)(KARGS()->in[5]))
#define w_ada ((const float*)(const GAS float*)(KARGS()->in[6]))
#define b_ada ((const float*)(const GAS float*)(KARGS()->in[7]))
#define norm_g ((const float*)(const GAS float*)(KARGS()->in[8]))
#define w_ffn_in ((const float*)(const GAS float*)(KARGS()->in[9]))
#define w_ffn_out ((const float*)(const GAS float*)(KARGS()->in[10]))
#define w_in ((const float*)(const GAS float*)(KARGS()->in[11]))
#define w_out ((const float*)(const GAS float*)(KARGS()->in[12]))
#define q_norm_g ((const float*)(const GAS float*)(KARGS()->in[13]))
#define k_norm_g ((const float*)(const GAS float*)(KARGS()->in[14]))
#define sink ((const float*)(const GAS float*)(KARGS()->in[15]))
#define pool_w ((const float*)(const GAS float*)(KARGS()->in[16]))
#define pool_scale ((const float*)(const GAS float*)(KARGS()->in[17]))
#define conv_w ((const float*)(const GAS float*)(KARGS()->in[18]))
#define mod ((float*)(opq(ws) + WS_MOD))
#define ropeC ((float*)(opq(ws) + WS_ROPE))
#define ropeS (ropeC + 1024)
#define WIN ((bf16*)(opq(ws) + WS_WIN))
#define WOUT ((bf16*)(opq(ws) + WS_WOUT))
#define CK ((bf16*)(opq(ws) + WS_CK))
#define CV ((bf16*)(opq(ws) + WS_CV))
#define WFO ((bf16*)(opq(ws) + WS_WFO))
#define WFI ((bf16*)(opq(ws) + WS_WFI))
#define XN ((bf16*)(opq(ws) + WS_XN))
#define HID ((bf16*)(opq(ws) + WS_HID))
#define QB ((bf16*)(opq(ws) + WS_Q))
#define KB ((bf16*)(opq(ws) + WS_K))
#define VB ((bf16*)(opq(ws) + WS_V))
#define U4 ((bf16*)(opq(ws) + WS_U4))
#define out ((float*)(GAS float*)(KARGS()->out))
#define newk (out + (size_t)MT * DM)
#define newv (newk + (size_t)16 * 2 * 256 * 128)

template <int l> __device__ __forceinline__ void layer_body(LAS unsigned char* L, unsigned char* lds, int tid, int lane, int blk, int G, int gw, int NGW, cg::grid_group& grid) {
        const float* mod_l = mod + (size_t)l * 9 * 9216;
        const float* xc_in = l == 0 ? x_prompt : out; const float* xl_in = l == 0 ? x_sample : out + (size_t)MC * DM;
#ifndef NO_NORM
        norm_rows(xc_in, xl_in, XN, mod_l, 0, norm_g + (l * 3 + 0) * DM, gw, NGW, lane);
#endif
        grid.sync();
#ifndef NO_G1
        { pg8::Gemm g{XN, WFI + (size_t)(l * 2 + 0) * 5632 * 1024, MT, 5632, 1024}; pg8::StaticOrder S; S.init(MT, 5632, G, blk); pg8::EpiSwiGLU E{HID};
          pg8::gemm_phase<pg8::EpiSwiGLU, pg8::StaticOrder, true, true>(L, g, S, E); }
#endif
        grid.sync();
#ifndef NO_G2
        { pg8::Gemm g{HID, WFO + (size_t)(l * 2 + 0) * 1024 * 2816, MT, 1024, 2816}; pg8::StaticOrder S; S.init(MT, 1024, G, blk); pg8::EpiResid E{xc_in, xl_in, out, mod_l + 2 * DM, 0.5f};
          pg8::gemm_phase<pg8::EpiResid, pg8::StaticOrder, true, true>(L, g, S, E); }
#endif
        grid.sync();
#ifndef NO_NORM
        norm_rows(out, out + (size_t)MC * DM, XN, mod_l, 1, norm_g + (l * 3 + 1) * DM, gw, NGW, lane);
#endif
        grid.sync();
#ifndef NO_G3
        { pg8::Gemm g{XN, WIN + (size_t)l * NIN * 1024, MT, NIN, 1024}; pg8::StaticOrder S; S.init(MT, NIN, G, blk);
          pg8::EpiIn E{QB, KB, VB, U4, newk + (size_t)l * 256 * 128, newv + (size_t)l * 256 * 128, q_norm_g + l * 64, k_norm_g + l * 64, ropeC, ropeS};
          pg8::gemm_phase<pg8::EpiIn, pg8::StaticOrder, true, true>(L, g, S, E); }
#endif
        grid.sync();
        {
            bf16* MIX = XN;
            const float LOG2E = 1.4426950408889634f;
#ifndef NO_ATT
            for (int i = 0; i < 5; ++i) {
                const int idx = blk + i * G;
                if (idx < 1024) {
                    const int qb = idx & 15, h = (idx >> 4) & 7, b = idx >> 7, kvh = h >> 2, q0 = qb * 256;
                    const int kstart = q0 - 128 < 0 ? 0 : q0 - 128, kend = q0 + 384 > 4096 ? 4096 : q0 + 384;
                    const size_t row0 = (size_t)MC + (size_t)b * 4096 + q0;
                    const size_t crow0 = (size_t)(b * 2 + l) * 512;
                    const size_t krow0 = (size_t)MC + (size_t)b * 4096 + kstart;
                    attn_body::attn_unit<8>((const attn_body::bf16*)(QB + row0 * 512 + h * 64), (attn_body::bf16*)(MIX + row0 * 1024 + h * 64),
                        (const attn_body::bf16*)(CK + crow0 * 128 + kvh * 64), (const attn_body::bf16*)(CV + crow0 * 128 + kvh * 64),
                        (const attn_body::bf16*)(KB + krow0 * 128 + kvh * 64), (const attn_body::bf16*)(VB + krow0 * 128 + kvh * 64),
                        8, 8 + (kend - kstart) / 64, kstart - q0, sink[l * 8 + h] * LOG2E, (char*)lds);
                } else if (idx < 1152) {
                    const int j = idx - 1024, h = j & 7, b = j >> 3, kvh = h >> 2;
                    const size_t row0 = (size_t)b * 256;
                    attn_body::attn_unit<8>((const attn_body::bf16*)(QB + row0 * 512 + h * 64), (attn_body::bf16*)(MIX + row0 * 1024 + h * 64),
                        (const attn_body::bf16*)(KB + row0 * 128 + kvh * 64), (const attn_body::bf16*)(VB + row0 * 128 + kvh * 64),
                        (const attn_body::bf16*)(KB + row0 * 128 + kvh * 64), (const attn_body::bf16*)(VB + row0 * 128 + kvh * 64),
                        4, 4, 0, sink[l * 8 + h] * LOG2E, (char*)lds);
                }
            }
#endif
#ifndef NO_PC
            poolconv_rows(U4, MIX, conv_w + l * 768, blk, G, tid);
#endif
        }
        grid.sync();
#ifndef NO_G2
        { pg8::Gemm g{XN, WOUT + (size_t)l * 1024 * 1024, MT, 1024, 1024}; pg8::StaticOrder S; S.init(MT, 1024, G, blk); pg8::EpiResid E{out, out + (size_t)MC * DM, out, mod_l + 5 * DM, 1.0f};
          pg8::gemm_phase<pg8::EpiResid, pg8::StaticOrder, true, true>(L, g, S, E); }
#endif
        grid.sync();
#ifndef NO_NORM
        norm_rows(out, out + (size_t)MC * DM, XN, mod_l, 2, norm_g + (l * 3 + 2) * DM, gw, NGW, lane);
#endif
        grid.sync();
#ifndef NO_G1
        { pg8::Gemm g{XN, WFI + (size_t)(l * 2 + 1) * 5632 * 1024, MT, 5632, 1024}; pg8::StaticOrder S; S.init(MT, 5632, G, blk); pg8::EpiSwiGLU E{HID};
          pg8::gemm_phase<pg8::EpiSwiGLU, pg8::StaticOrder, true, true>(L, g, S, E); }
#endif
        grid.sync();
#ifndef NO_G2
        { pg8::Gemm g{HID, WFO + (size_t)(l * 2 + 1) * 1024 * 2816, MT, 1024, 2816}; pg8::StaticOrder S; S.init(MT, 1024, G, blk); pg8::EpiResid E{out, out + (size_t)MC * DM, out, mod_l + 8 * DM, 0.5f};
          pg8::gemm_phase<pg8::EpiResid, pg8::StaticOrder, true, true>(L, g, S, E); }
#endif
        if (l == 0) grid.sync();
    }

__global__ void __launch_bounds__(NWAVES * 64, 2) fwd_mega(Args args) {
    extern __shared__ __attribute__((aligned(16))) unsigned char lds[];
    cg::grid_group grid = cg::this_grid();
    LAS unsigned char* L = (LAS unsigned char*)lds;
    const int tid = threadIdx.x, lane = tid & 63, wave = __builtin_amdgcn_readfirstlane(tid >> 6);
    const int G = gridDim.x, blk = blockIdx.x, gw = blk * NWAVES + wave, NGW = G * NWAVES;
#ifndef NO_P0
    {
        LAS float* sct = (LAS float*)(L + 69632);
        for (int i = tid; i < 9 * 1024; i += 512) { const float v = i < 8192 ? cvec[i] : c_ctx[i - 8192]; sct[i] = v / (1.0f + __expf(-v)); }
        __syncthreads();
        LAS float* scr = (LAS float*)(L + wave * 8448);
        constexpr int I_FI = 16 * 176, I_FO = 44 * 32, I_IN = 16 * 56, I_OUT = 16 * 32, I_FOLD = 128, I_MOD = 144;
        constexpr int NIT = 4 * I_FI + 4 * I_FO + 2 * I_IN + 2 * I_OUT + 2 * I_FOLD + 2 * I_MOD;
        for (int it = gw; it < NIT; it += NGW) {
            int r = it;
            if (r < 2 * I_MOD) {
                const int l = r / I_MOD, j = (r % I_MOD) * 64 + lane;
                const float* wp = w_ada + (size_t)l * 1024 * 9216 + j;
                float a[9] = {0.f, 0.f, 0.f, 0.f, 0.f, 0.f, 0.f, 0.f, 0.f};
                for (int k = 0; k < 1024; k += 4) {
                    const float w0 = wp[(size_t)k * 9216], w1 = wp[(size_t)(k + 1) * 9216], w2 = wp[(size_t)(k + 2) * 9216], w3 = wp[(size_t)(k + 3) * 9216];
#pragma unroll
                    for (int ci = 0; ci < 9; ++ci) { const f32x4 s = *(const LAS f32x4*)(sct + ci * 1024 + k); a[ci] += (s.x * w0 + s.y * w1) + (s.z * w2 + s.w * w3); }
                }
                const float bb = b_ada[l * 9216 + j];
#pragma unroll
                for (int ci = 0; ci < 9; ++ci) mod[((size_t)l * 9 + ci) * 9216 + j] = a[ci] + bb;
                continue;
            }
            r -= 2 * I_MOD;
            if (r < 2 * I_FOLD) { const int l = r / I_FOLD; fold_item(w_out + (size_t)l * 1024 * 1024, pool_w + l * 4 * 4096, pool_scale + l * 256, WOUT + (size_t)l * 1024 * 1024, r % I_FOLD, lane); continue; }
            r -= 2 * I_FOLD;
            if (r < 4 * I_FI) { const int mi = r / I_FI; transpose_item(w_ffn_in + (size_t)mi * 1024 * 5632, 1024, 5632, WFI + (size_t)mi * 5632 * 1024, 1, scr, r % I_FI, lane); continue; }
            r -= 4 * I_FI;
            if (r < 4 * I_FO) { const int mi = r / I_FO; transpose_item(w_ffn_out + (size_t)mi * 2816 * 1024, 2816, 1024, WFO + (size_t)mi * 1024 * 2816, 0, scr, r % I_FO, lane); continue; }
            r -= 4 * I_FO;
            if (r < 2 * I_IN) { const int l = r / I_IN; transpose_item(w_in + (size_t)l * 1024 * NIN, 1024, NIN, WIN + (size_t)l * NIN * 1024, 2, scr, r % I_IN, lane); continue; }
            r -= 2 * I_IN;
            { const int l = r / I_OUT; transpose_item(w_out + (size_t)l * 1024 * 1024, 1024, 1024, WOUT + (size_t)l * 1024 * 1024, 3, scr, r % I_OUT, lane); }
        }
        for (size_t i = (size_t)blk * 512 + tid; i < (size_t)2 * 262144; i += (size_t)G * 512) {
            const bool isv = i >= 262144; const size_t e = (isv ? i - 262144 : i) * 4;
            const f32x4 v = *(const f32x4*)((isv ? cache_v : cache_k) + e);
            *(unsigned long long*)((isv ? CV : CK) + e) = (unsigned long long)pk2(v.x, v.y) | ((unsigned long long)pk2(v.z, v.w) << 32);
        }
        if (blk == 0) for (int i = tid; i < 1024; i += 512) { const int p = i >> 4, fi = i & 15; const float inv = powf(10000.0f, -(float)(2 * fi) / 32.0f); const float ang = (float)p * inv; ropeC[i] = cosf(ang); ropeS[i] = sinf(ang); }
    }
#endif
    grid.sync();

    layer_body<0>(L, lds, tid, lane, blk, G, gw, NGW, grid);
    layer_body<1>(L, lds, tid, lane, blk, G, gw, NGW, grid);
}

#undef out
#undef mod
#undef x_prompt
#undef x_sample
#undef cache_k
#undef cache_v
#undef cvec
#undef c_ctx
#undef w_ada
#undef b_ada
#undef norm_g
#undef w_ffn_in
#undef w_ffn_out
#undef w_in
#undef w_out
#undef q_norm_g
#undef k_norm_g
#undef sink
#undef pool_w
#undef pool_scale
#undef conv_w
#undef ws
extern "C" void kernel_launch(void* const* d_in, const int* in_sizes, int n_in, void* d_out, int out_size, void* d_ws, size_t ws_size, hipStream_t stream) {
    static int grid = 0;
    if (grid == 0) {
        int dev = 0, cus = 0, per_cu = 0;
        (void)hipGetDevice(&dev);
        (void)hipDeviceGetAttribute(&cus, hipDeviceAttributeMultiprocessorCount, dev);
        (void)hipFuncSetAttribute((const void*)fwd_mega, hipFuncAttributeMaxDynamicSharedMemorySize, LDS_BYTES);
        (void)hipOccupancyMaxActiveBlocksPerMultiprocessor(&per_cu, (const void*)fwd_mega, NWAVES * 64, LDS_BYTES);
        if (n_in != 19 || ws_size < WS_END) fprintf(stderr, "kernel_launch: unexpected n_in %d or ws_size %zu\n", n_in, ws_size);
        if (per_cu < 1) fprintf(stderr, "kernel_launch: occupancy query says %d blocks/CU\n", per_cu);
        grid = cus > 0 ? cus : 256;
    }
    Args a{};
    for (int i = 0; i < 19; ++i) a.in[i] = (const float*)d_in[i];
    a.out = (float*)d_out; a.ws = (unsigned char*)d_ws;
    void* kargs[] = {&a};
    hipError_t e = hipLaunchCooperativeKernel((const void*)fwd_mega, dim3(grid), dim3(NWAVES * 64), kargs, LDS_BYTES, stream);
    if (e != hipSuccess) fprintf(stderr, "cooperative launch failed: %s (grid %d)\n", hipGetErrorString(e), grid);
}
```

```cpp
#include <hip/hip_runtime.h>
#include <hip/hip_cooperative_groups.h>
#include <hip/hip_bf16.h>
#include <cstdio>
#include <cstdint>
#include <cmath>
namespace cg = cooperative_groups;
namespace pg8 {
#define PG8_LAS __attribute__((address_space(3)))
typedef unsigned short bf16_t;
typedef short bf16x8 __attribute__((ext_vector_type(8)));
typedef float f32x4 __attribute__((ext_vector_type(4)));
typedef unsigned u32x4 __attribute__((ext_vector_type(4)));
constexpr int BM = 256, BK = 64, HALF = 128, HTB = HALF * BK * 2  , STAGE_BYTES = 8 * HTB, NXCD = 8, WGM = 8;

__host__ __device__ __forceinline__ int lds_byte(int r, int c) { const int st = (r >> 4) * 2 + (c >> 5), rr = r & 15, cc = c & 31, ob = rr * 64 + cc * 2; return st * 1024 + (ob ^ (((ob >> 9) & 1) << 5)); }
__host__ __device__ __forceinline__ void stage_rc(int b, int& R, int& C) { const int st = b / 1024, sb = b % 1024, swz = sb ^ (((sb >> 9) & 1) << 5); R = (st >> 1) * 16 + swz / 64; C = (st & 1) * 32 + (swz % 64) / 2; }
__host__ __device__ __forceinline__ int perm32(int rho) { const int n = rho >> 4, i = rho & 15; return 8 * (i >> 2) + 4 * n + (i & 3); }

struct Unit { int pm, pn; };
struct Gemm { const bf16_t* A; const bf16_t* Bt; int M, N, K; };

struct StaticOrder {
    int nM, nN, nwg, G, c;
    __host__ __device__ void init(int M, int N, int G_, int c_) { nM = M / BM; nN = N / BM; nwg = nM * nN; G = G_; c = c_; }
    __host__ __device__ bool next(int i, Unit& u) const {
        const long L = (long)i * G + c; if (L >= nwg) return false;
        int wgid = (int)L; { const int q = nwg / NXCD, r = nwg % NXCD, xcd = wgid % NXCD, off = wgid / NXCD; wgid = (xcd < r ? xcd * (q + 1) : r * (q + 1) + (xcd - r) * q) + off; }
        const int nig = WGM * nN, gid = wgid / nig, fm = gid * WGM, gsz = (nM - fm) < WGM ? (nM - fm) : WGM;
        u.pm = fm + ((wgid % nig) % gsz); u.pn = (wgid % nig) / gsz; return true;
    }
    __device__ __forceinline__ void a_ready(const Unit&) const {}
    __device__ __forceinline__ void done(const Unit&) const {}
};

__device__ __forceinline__ unsigned cvt_pk_bf16(float lo, float hi) { unsigned r; asm volatile("v_cvt_pk_bf16_f32 %0, %1, %2" : "=v"(r) : "v"(lo), "v"(hi)); return r; }
typedef float f32x2 __attribute__((ext_vector_type(2)));
typedef int i32x4 __attribute__((ext_vector_type(4))); typedef int i32x8 __attribute__((ext_vector_type(8)));
template <class Epi, class Sched, bool ALIGN_EPI = false, bool SP2 = false, bool F8 = false>
__device__ __forceinline__ void gemm_phase(PG8_LAS unsigned char* lds, const Gemm g, const Sched& S, const Epi& E) {
    int tid_ = threadIdx.x; asm volatile("" : "+v"(tid_));
    const int tid = tid_, wid = __builtin_amdgcn_readfirstlane(tid >> 6), lane = tid & 63, wr = wid >> 2, wc = wid & 3, fr = lane & 15, fq = lane >> 4;
    int K_ = g.K; asm volatile("" : "+s"(K_));
    const int K = K_, nt = K / BK;
    unsigned voffA[2], voffB[2];
#pragma unroll
    for (int i = 0; i < 2; ++i) { int R, C; stage_rc(tid * 16 + i * 8192, R, C); const int Rb = Epi::PERM ? ((R & ~31) + perm32(R & 31)) : R;
        voffA[i] = (unsigned)(R * K + C) * 2u; voffB[i] = (unsigned)(Rb * K + C) * 2u; }
    const size_t kstep = (size_t)(BK * 2);
    const size_t hstep = (size_t)HALF * K * 2;
    const size_t tstep = 2 * hstep;
    const unsigned ldsw = (unsigned)wid * 1024u;
    const int aoff = lds_byte(wr * 64 + fr, fq * 8), boff = lds_byte(wc * 32 + fr, fq * 8);
#define PG8_SA(b, h) (((b) * 2 + (h)) * HTB)
#define PG8_SB(b, h) ((4 + (b) * 2 + (h)) * HTB)
#define PG8_STAGE(bufoff, gbase, voff) do { _Pragma("unroll") for (int _i = 0; _i < 2; ++_i) \
        __builtin_amdgcn_global_load_lds((const unsigned*)((const char*)(gbase) + (voff)[_i]), (PG8_LAS unsigned*)(lds + (bufoff) + ldsw + _i * 8192), 16, 0, 0); } while (0)
#define PG8_LD8(dst, i, off) dst##8[i] = __builtin_shufflevector(*(const PG8_LAS i32x4*)(lds + (off)), *(const PG8_LAS i32x4*)(lds + (off) + 1024), 0, 1, 2, 3, 4, 5, 6, 7)
#define PG8_LDA(dst, b, h) do { if constexpr (F8) { _Pragma("unroll") for (int m = 0; m < 4; ++m) PG8_LD8(dst, m, PG8_SA(b, h) + aoff + m * 2048); } else { \
        _Pragma("unroll") for (int m = 0; m < 4; ++m) _Pragma("unroll") for (int k = 0; k < 2; ++k) dst[m][k] = *(const PG8_LAS bf16x8*)(lds + PG8_SA(b, h) + aoff + m * 2048 + k * 1024); } } while (0)
#define PG8_LDB(dst, b, h) do { if constexpr (F8) { _Pragma("unroll") for (int n = 0; n < 2; ++n) PG8_LD8(dst, n, PG8_SB(b, h) + boff + n * 2048); } else { \
        _Pragma("unroll") for (int n = 0; n < 2; ++n) _Pragma("unroll") for (int k = 0; k < 2; ++k) dst[n][k] = *(const PG8_LAS bf16x8*)(lds + PG8_SB(b, h) + boff + n * 2048 + k * 1024); } } while (0)
#define PG8_MMA(ai, bj, At, Bt) do { __builtin_amdgcn_s_setprio(1); if constexpr (F8) { _Pragma("unroll") for (int m = 0; m < 4; ++m) _Pragma("unroll") for (int n = 0; n < 2; ++n) \
        asm volatile("v_mfma_f32_16x16x128_f8f6f4 %0, %1, %2, %0" : "+v"(acc[ai][bj][m][n]) : "v"(Bt##8[n]), "v"(At##8[m])); } else { \
        _Pragma("unroll") for (int m = 0; m < 4; ++m) _Pragma("unroll") for (int n = 0; n < 2; ++n) _Pragma("unroll") for (int k = 0; k < 2; ++k) \
        acc[ai][bj][m][n] = __builtin_amdgcn_mfma_f32_16x16x32_bf16(Bt[n][k], At[m][k], acc[ai][bj][m][n], 0, 0, 0); } __builtin_amdgcn_s_setprio(0); } while (0)
#define PG8_WAIT_V(n) asm volatile("s_waitcnt vmcnt(" #n ")" ::: "memory")
#define PG8_WAIT_L(n) asm volatile("s_waitcnt lgkmcnt(" #n ")" ::: "memory")
#define PG8_BAR __builtin_amdgcn_s_barrier()
#define PG8_SCHED __builtin_amdgcn_sched_barrier(0)
    Unit cur, nxt; int ui = 0;
    if (!S.next(0, cur)) return;
    f32x4 acc[2][2][4][2];
#pragma unroll
    for (int a = 0; a < 2; ++a)
#pragma unroll
        for (int b = 0; b < 2; ++b)
#pragma unroll
            for (int m = 0; m < 4; ++m)
#pragma unroll
                for (int n = 0; n < 2; ++n) { acc[a][b][m][n] = (f32x4){0.f, 0.f, 0.f, 0.f}; if constexpr (F8) asm volatile("" : "+v"(acc[a][b][m][n])); }
    bf16x8 At[4][2], B0[2][2], B1[2][2];
    i32x8 At8[4], B08[2], B18[2];
    const char* cA = (const char*)g.A + (size_t)cur.pm * tstep; const char* cB = (const char*)g.Bt + (size_t)cur.pn * tstep;
    S.a_ready(cur);
    if constexpr (SP2) {
        PG8_STAGE(PG8_SB(0, 0), cB, voffB); PG8_STAGE(PG8_SB(0, 1), cB + hstep, voffB); PG8_STAGE(PG8_SA(0, 0), cA, voffA); PG8_STAGE(PG8_SA(0, 1), cA + hstep, voffA);
        if (wr == 1) PG8_BAR;
        PG8_WAIT_V(2); PG8_BAR;
        PG8_STAGE(PG8_SB(1, 0), cB + kstep, voffB); PG8_STAGE(PG8_SA(1, 0), cA + kstep, voffA); PG8_STAGE(PG8_SB(1, 1), cB + hstep + kstep, voffB);
        PG8_WAIT_V(6); PG8_BAR;
    } else {
        PG8_STAGE(PG8_SB(0, 0), cB, voffB); PG8_STAGE(PG8_SA(0, 0), cA, voffA); PG8_STAGE(PG8_SB(0, 1), cB + hstep, voffB); PG8_STAGE(PG8_SA(0, 1), cA + hstep, voffA);
        if (wr == 1) PG8_BAR;
        PG8_WAIT_V(4); PG8_BAR;
        PG8_STAGE(PG8_SB(1, 0), cB + kstep, voffB); PG8_STAGE(PG8_SA(1, 0), cA + kstep, voffA); PG8_STAGE(PG8_SB(1, 1), cB + hstep + kstep, voffB);
        PG8_WAIT_V(6); PG8_BAR;
    }
    for (;;) {
        const bool has_next = S.next(ui + 1, nxt);
        const char* nA = has_next ? (const char*)g.A + (size_t)nxt.pm * tstep : cA; const char* nB = has_next ? (const char*)g.Bt + (size_t)nxt.pn * tstep : cB;
        for (int t = 0; t < nt; t += 2) {
            const bool last = (t == nt - 2);
            const char* a1 = cA + (size_t)(t + 1) * kstep;
            const char* a2 = last ? nA : cA + (size_t)(t + 2) * kstep; const char* b2 = last ? nB : cB + (size_t)(t + 2) * kstep;
            const char* a3 = a2 + kstep; const char* b3 = b2 + kstep;
            if (last && has_next) S.a_ready(nxt);
            if constexpr (SP2) {
            PG8_LDB(B0, 0, 0); PG8_LDB(B1, 0, 1); PG8_SCHED; PG8_LDA(At, 0, 0); PG8_STAGE(PG8_SA(1, 1), a1 + hstep, voffA);
            PG8_WAIT_V(8); PG8_WAIT_L(0); PG8_BAR; PG8_MMA(0, 0, At, B0); PG8_MMA(0, 1, At, B1); PG8_BAR; PG8_SCHED;
            PG8_LDA(At, 0, 1); PG8_STAGE(PG8_SB(0, 0), b2, voffB); PG8_STAGE(PG8_SB(0, 1), b2 + hstep, voffB); PG8_STAGE(PG8_SA(0, 0), a2, voffA);
            PG8_WAIT_V(8); PG8_WAIT_L(0); PG8_BAR; PG8_MMA(1, 0, At, B0); PG8_MMA(1, 1, At, B1); PG8_BAR; PG8_SCHED;
            PG8_LDB(B0, 1, 0); PG8_LDB(B1, 1, 1); PG8_SCHED; PG8_LDA(At, 1, 0); PG8_STAGE(PG8_SA(0, 1), a2 + hstep, voffA);
            PG8_WAIT_V(8); PG8_WAIT_L(0); PG8_BAR; PG8_MMA(0, 0, At, B0); PG8_MMA(0, 1, At, B1); PG8_BAR; PG8_SCHED;
            PG8_LDA(At, 1, 1); PG8_STAGE(PG8_SB(1, 0), b3, voffB); PG8_STAGE(PG8_SB(1, 1), b3 + hstep, voffB); PG8_STAGE(PG8_SA(1, 0), a3, voffA);
            PG8_WAIT_V(8); PG8_WAIT_L(0); PG8_BAR; PG8_MMA(1, 0, At, B0); PG8_MMA(1, 1, At, B1); PG8_BAR; PG8_SCHED;
            } else {
            PG8_LDB(B0, 0, 0); PG8_SCHED; PG8_LDA(At, 0, 0); PG8_STAGE(PG8_SA(1, 1), a1 + hstep, voffA);
            PG8_WAIT_L(8); PG8_BAR; PG8_WAIT_L(0); PG8_MMA(0, 0, At, B0); PG8_BAR; PG8_SCHED;
            PG8_LDB(B1, 0, 1); PG8_STAGE(PG8_SB(0, 0), b2, voffB);
            PG8_BAR; PG8_WAIT_L(0); PG8_MMA(0, 1, At, B1); PG8_BAR;
            PG8_LDA(At, 0, 1); PG8_STAGE(PG8_SA(0, 0), a2, voffA);
            PG8_BAR; PG8_WAIT_L(0); PG8_MMA(1, 0, At, B0); PG8_BAR; PG8_SCHED;
            PG8_STAGE(PG8_SB(0, 1), b2 + hstep, voffB);
            PG8_WAIT_V(6); PG8_BAR; PG8_MMA(1, 1, At, B1); PG8_BAR;
            PG8_LDB(B0, 1, 0); PG8_SCHED; PG8_LDA(At, 1, 0); PG8_STAGE(PG8_SA(0, 1), a2 + hstep, voffA);
            PG8_WAIT_L(8); PG8_BAR; PG8_WAIT_L(0); PG8_MMA(0, 0, At, B0); PG8_BAR; PG8_SCHED;
            PG8_LDB(B1, 1, 1); PG8_STAGE(PG8_SB(1, 0), b3, voffB);
            PG8_BAR; PG8_WAIT_L(0); PG8_MMA(0, 1, At, B1); PG8_BAR;
            PG8_LDA(At, 1, 1); PG8_STAGE(PG8_SA(1, 0), a3, voffA);
            PG8_BAR; PG8_WAIT_L(0); PG8_MMA(1, 0, At, B0); PG8_BAR; PG8_SCHED;
            PG8_STAGE(PG8_SB(1, 1), b3 + hstep, voffB);
            PG8_WAIT_V(6); PG8_BAR; PG8_MMA(1, 1, At, B1); PG8_BAR;
            }
        }
        if constexpr (ALIGN_EPI) { if (wr == 0) PG8_BAR; }
        if constexpr (!Epi::AFTER_DRAIN) { E(acc, cur, wr, wc, fr, fq); S.done(cur); }
        if (!has_next) break;
#pragma unroll
        for (int a = 0; a < 2; ++a)
#pragma unroll
            for (int b = 0; b < 2; ++b)
#pragma unroll
                for (int m = 0; m < 4; ++m)
#pragma unroll
                    for (int n = 0; n < 2; ++n) { acc[a][b][m][n] = (f32x4){0.f, 0.f, 0.f, 0.f}; if constexpr (F8) asm volatile("" : "+v"(acc[a][b][m][n])); }
        cur = nxt; cA = nA; cB = nB; ++ui;
        if constexpr (ALIGN_EPI) { if (wr == 1) PG8_BAR; }
    }
    PG8_WAIT_V(0);
    if constexpr (!ALIGN_EPI) { if (wr == 0) PG8_BAR; }
    PG8_BAR;
    if constexpr (Epi::AFTER_DRAIN) { E.fused(acc, cur, wr, wc, fr, fq, lds, wid, lane); S.done(cur); }
#undef PG8_SA
#undef PG8_SB
#undef PG8_STAGE
#undef PG8_LDA
#undef PG8_LD8
#undef PG8_LDB
#undef PG8_MMA
#undef PG8_WAIT_V
#undef PG8_WAIT_L
#undef PG8_BAR
#undef PG8_SCHED
}
}
__device__ __forceinline__ float clamp8(float v) { return __builtin_fminf(__builtin_fmaxf(v, -440.0f), 440.0f); }
__device__ __forceinline__ unsigned pk4_fp8(float a, float b, float c, float d) {
    int w = __builtin_amdgcn_cvt_pk_fp8_f32(clamp8(a), clamp8(b), 0, false); w = __builtin_amdgcn_cvt_pk_fp8_f32(clamp8(c), clamp8(d), w, true); return (unsigned)w; }
constexpr float F8_SA = 16.0f, F8_SW = 256.0f, F8_SH = 8.0f;
namespace pg8 {
typedef unsigned u32x2 __attribute__((ext_vector_type(2)));
__device__ __forceinline__ float silu_f(float g) { return g * __builtin_amdgcn_rcpf(1.0f + __builtin_amdgcn_exp2f(-1.4426950408889634f * g)); }
template <bool F8> struct EpiSwiGLU {
    static constexpr bool PERM = true, AFTER_DRAIN = false;
    bf16_t* H;
    __device__ __forceinline__ void operator()(const f32x4 (&acc)[2][2][4][2], const Unit& u, int wr, int wc, int fr, int fq) const {
        asm volatile("" : "+v"(fr), "+v"(fq));
        const int row0 = u.pm * BM + wr * 64 + fr, col0 = u.pn * 128 + wc * 32 + 8 * fq;
        const float us = F8 ? 1.0f / (F8_SA * F8_SW) : 1.0f, hs = F8 ? F8_SH : 1.0f;
#pragma unroll
        for (int ai = 0; ai < 2; ++ai)
#pragma unroll
            for (int m = 0; m < 4; ++m) {
                const f32x4 g0 = acc[ai][0][m][0] * us, g1 = acc[ai][0][m][1] * us, u0 = acc[ai][1][m][0] * (us * hs), u1 = acc[ai][1][m][1] * (us * hs);
                const float h0 = silu_f(g0[0]) * u0[0], h1 = silu_f(g0[1]) * u0[1], h2 = silu_f(g0[2]) * u0[2], h3 = silu_f(g0[3]) * u0[3];
                const float h4 = silu_f(g1[0]) * u1[0], h5 = silu_f(g1[1]) * u1[1], h6 = silu_f(g1[2]) * u1[2], h7 = silu_f(g1[3]) * u1[3];
                if constexpr (F8) {
                    unsigned char* rowp = (unsigned char*)H + (size_t)(row0 + ai * HALF + m * 16) * 2816 + col0;
                    u32x2 w; w.x = pk4_fp8(h0, h1, h2, h3); w.y = pk4_fp8(h4, h5, h6, h7); *(u32x2*)rowp = w;
                } else {
                    bf16_t* rowp = H + (size_t)(row0 + ai * HALF + m * 16) * 2816 + col0;
                    u32x4 w; w.x = cvt_pk_bf16(h0, h1); w.y = cvt_pk_bf16(h2, h3); w.z = cvt_pk_bf16(h4, h5); w.w = cvt_pk_bf16(h6, h7); *(u32x4*)rowp = w;
                }
            }
    }
};
struct EpiResid {
    static constexpr bool PERM = false, AFTER_DRAIN = false;
    const float* xc; const float* xl; float* out; const float* gate_l; float gs;
    __device__ __forceinline__ void operator()(const f32x4 (&acc)[2][2][4][2], const Unit& u, int wr, int wc, int fr, int fq) const {
        asm volatile("" : "+v"(fr), "+v"(fq));
        const int cidx = u.pm < 16 ? 8 : ((u.pm - 16) >> 4);
        const float* gate = gate_l + (size_t)cidx * 9 * 1024;
        const int col0 = u.pn * BM + wc * 32 + 4 * fq;
        const float* xin = u.pm < 16 ? xc + (size_t)(u.pm * BM) * 1024 : xl + (size_t)(u.pm * BM - 4096) * 1024;
        float* xo = out + (size_t)(u.pm * BM) * 1024;
        f32x4 gv[2][2];
#pragma unroll
        for (int bj = 0; bj < 2; ++bj)
#pragma unroll
            for (int n = 0; n < 2; ++n) gv[bj][n] = *(const f32x4*)(gate + col0 + bj * HALF + n * 16) * gs;
#pragma unroll
        for (int ai = 0; ai < 2; ++ai)
#pragma unroll
            for (int m = 0; m < 4; ++m) {
                const size_t off = (size_t)(ai * HALF + wr * 64 + m * 16 + fr) * 1024 + col0;
#pragma unroll
                for (int bj = 0; bj < 2; ++bj)
#pragma unroll
                    for (int n = 0; n < 2; ++n) {
                        const f32x4 xv = *(const f32x4*)(xin + off + bj * HALF + n * 16);
                        *(f32x4*)(xo + off + bj * HALF + n * 16) = xv + gv[bj][n] * acc[ai][bj][m][n];
                    }
                if (m & 1) asm volatile("" ::: "memory");
            }
    }
};
struct EpiIn {
    static constexpr bool PERM = true, AFTER_DRAIN = false;
    bf16_t *Q, *K, *V, *U4; float* newk; float* newv; const float *qg, *kg; const float *ropeC, *ropeS;
    __device__ __forceinline__ void operator()(const f32x4 (&acc)[2][2][4][2], const Unit& u, int wr, int wc, int fr, int fq) const {
        asm volatile("" : "+v"(fr), "+v"(fq));
        const int pm = u.pm, pn = u.pn;
        if (pn >= 3) {
#pragma unroll
            for (int ai = 0; ai < 2; ++ai)
#pragma unroll
                for (int m = 0; m < 4; ++m) {
                    bf16_t* rowp = U4 + (size_t)(pm * BM + ai * HALF + wr * 64 + m * 16 + fr) * 1024 + (pn - 3) * 256 + wc * 32 + 8 * fq;
#pragma unroll
                    for (int bj = 0; bj < 2; ++bj) { const f32x4 v0 = acc[ai][bj][m][0], v1 = acc[ai][bj][m][1];
                        u32x4 w; w.x = cvt_pk_bf16(v0[0], v0[1]); w.y = cvt_pk_bf16(v0[2], v0[3]); w.z = cvt_pk_bf16(v1[0], v1[1]); w.w = cvt_pk_bf16(v1[2], v1[3]);
                        *(u32x4*)(rowp + bj * HALF) = w; }
                }
            return;
        }
        const bool latent = pm >= 16, isq = pn < 2, isv = (!isq) && wc >= 2;
        const float* g = isq ? qg : kg;
        const f32x4 g0 = *(const f32x4*)(g + 4 * fq), g1 = *(const f32x4*)(g + 16 + 4 * fq), g2 = *(const f32x4*)(g + 32 + 4 * fq), g3 = *(const f32x4*)(g + 48 + 4 * fq);
        const float C2 = 0.125f * 1.4426950408889634f;
#pragma unroll
        for (int ai = 0; ai < 2; ++ai)
#pragma unroll
            for (int m = 0; m < 4; ++m) {
                const int s = ai * HALF + wr * 64 + m * 16 + fr; const size_t row = (size_t)pm * BM + s;
                f32x4 a0 = acc[ai][0][m][0], a1 = acc[ai][0][m][1], b0 = acc[ai][1][m][0], b1 = acc[ai][1][m][1];
                if (!isv) {
                    float ss = (a0[0] * a0[0] + a0[1] * a0[1]) + (a0[2] * a0[2] + a0[3] * a0[3]) + (a1[0] * a1[0] + a1[1] * a1[1]) + (a1[2] * a1[2] + a1[3] * a1[3])
                             + (b0[0] * b0[0] + b0[1] * b0[1]) + (b0[2] * b0[2] + b0[3] * b0[3]) + (b1[0] * b1[0] + b1[1] * b1[1]) + (b1[2] * b1[2] + b1[3] * b1[3]);
                    ss += __shfl_xor(ss, 16); ss += __shfl_xor(ss, 32);
                    const float rinv = 1.0f / sqrtf(ss * (1.0f / 64.0f) + 1e-6f);
                    a0 = a0 * rinv * g0; a1 = a1 * rinv * g1; b0 = b0 * rinv * g2; b1 = b1 * rinv * g3;
                    if (!latent && !isq) {
                        float* o = newk + ((size_t)(pm * 2) * 256 + s) * 128 + (wc & 1) * 64 + 4 * fq;
                        *(f32x4*)o = a0; *(f32x4*)(o + 16) = a1; *(f32x4*)(o + 32) = b0; *(f32x4*)(o + 48) = b1;
                    }
                    if (latent) {
                        const int rowpos = 4 * ((pm - 16) & 15) + 2 * ai + wr, colpos = 16 * m + fr;
                        const f32x4 cr = *(const f32x4*)(ropeC + rowpos * 16 + 4 * fq), sr = *(const f32x4*)(ropeS + rowpos * 16 + 4 * fq);
                        const f32x4 cc = *(const f32x4*)(ropeC + colpos * 16 + 4 * fq), sc = *(const f32x4*)(ropeS + colpos * 16 + 4 * fq);
                        const f32x4 t0 = a0 * cr - a1 * sr, t1 = a0 * sr + a1 * cr, t2 = b0 * cc - b1 * sc, t3 = b0 * sc + b1 * cc;
                        a0 = t0; a1 = t1; b0 = t2; b1 = t3;
                    }
                } else if (!latent) {
                    float* o = newv + ((size_t)(pm * 2) * 256 + s) * 128 + (wc & 1) * 64 + 4 * fq;
                    *(f32x4*)o = a0; *(f32x4*)(o + 16) = a1; *(f32x4*)(o + 32) = b0; *(f32x4*)(o + 48) = b1;
                }
                bf16_t* dst;
                if (isq) { a0 = a0 * C2; a1 = a1 * C2; b0 = b0 * C2; b1 = b1 * C2; dst = Q + row * 512 + (pn * 4 + wc) * 64 + 4 * fq; }
                else dst = (isv ? V : K) + row * 128 + (wc & 1) * 64 + 4 * fq;
                u32x2 w0, w1, w2, w3;
                w0.x = cvt_pk_bf16(a0[0], a0[1]); w0.y = cvt_pk_bf16(a0[2], a0[3]); w1.x = cvt_pk_bf16(a1[0], a1[1]); w1.y = cvt_pk_bf16(a1[2], a1[3]);
                w2.x = cvt_pk_bf16(b0[0], b0[1]); w2.y = cvt_pk_bf16(b0[2], b0[3]); w3.x = cvt_pk_bf16(b1[0], b1[1]); w3.y = cvt_pk_bf16(b1[2], b1[3]);
                *(u32x2*)dst = w0; *(u32x2*)(dst + 16) = w1; *(u32x2*)(dst + 32) = w2; *(u32x2*)(dst + 48) = w3;
                asm volatile("" ::: "memory");
            }
    }
};
}
namespace attn_body {
using bf16=__hip_bfloat16;
using bf16x8=__attribute__((ext_vector_type(8)))short;
using s16x4=__attribute__((ext_vector_type(4)))short;
using f32x16=__attribute__((ext_vector_type(16)))float;
using u32x4=__attribute__((ext_vector_type(4)))unsigned;
constexpr int D=64,QP=512,KP=128,OP=1024;
constexpr int NW=8,QBLK=32,QB=QBLK*NW,KVBLK=64;
constexpr int ATTN_UNIT_ROWS=QB;
__device__ __forceinline__ int crow(int r,int hi){return (r&3)+8*(r>>2)+4*hi;}
#define SBAR() __builtin_amdgcn_sched_barrier(0)
__device__ __forceinline__ void bmask(f32x16&p0,f32x16&p1,int dlt){
  const float NEG=-INFINITY;
  #pragma unroll
  for(int r=0;r<16;++r){int kv=dlt+(r&3)+8*(r>>2); if(kv>128||kv<-128)p0[r]=NEG; if(kv+32>128||kv+32<-128)p1[r]=NEG;}
}

constexpr int NSLOT=3, SLOTB=8192;
constexpr int LDS_K=0, LDS_V=NSLOT*SLOTB, LDS_WS=2*NSLOT*SLOTB, LDS_OST=LDS_WS+NW*64*4, LDS_BYTES=LDS_OST+NW*4096;
constexpr float C2=0.125f*1.4426950408889634f;
__device__ __forceinline__ void glds16(const void*gsrc,unsigned lds_dst){unsigned keep;
  asm volatile("s_mov_b32 %0, m0\n\ts_mov_b32 m0, %2\n\ts_nop 0\n\tglobal_load_lds_dwordx4 %1, off\n\ts_mov_b32 m0, %0":"=&s"(keep):"v"(gsrc),"s"(lds_dst):"memory");}
__device__ __forceinline__ float max3f(float a,float b,float c){float r;asm("v_max3_f32 %0, %1, %2, %3":"=v"(r):"v"(a),"v"(b),"v"(c));return r;}
__device__ __forceinline__ float max2f(float a,float b){float r;asm("v_max_f32_e32 %0, %1, %2":"=v"(r):"v"(a),"v"(b));return r;}
__device__ __forceinline__ float fadd_s(float a,float b){float r;asm("v_add_f32_e32 %0, %1, %2":"=v"(r):"v"(a),"v"(b));return r;}
__device__ __forceinline__ float fsub_s(float a,float b){float r;asm("v_sub_f32_e32 %0, %1, %2":"=v"(r):"v"(a),"v"(b));return r;}
typedef float f32x2_t __attribute__((ext_vector_type(2))); typedef __bf16 bf16x2_t __attribute__((ext_vector_type(2)));
__device__ __forceinline__ unsigned cvtpk_s(float lo,float hi){f32x2_t v={lo,hi};bf16x2_t b=__builtin_convertvector(v,bf16x2_t);return __builtin_bit_cast(unsigned,b);}
#define WAIT_BAR(N) asm volatile("s_waitcnt vmcnt(" #N ") lgkmcnt(0)\n\ts_barrier":::"memory")

__device__ __forceinline__ void qkt(f32x16&p0,f32x16&p1,const char*Kslot,const bf16x8*qr,const f32x16&negm,int r32,int hi){
  const char*kb=Kslot+hi*1024+r32*16;
  #pragma unroll
  for(int d0=0;d0<4;++d0){
    const bf16x8 b0=*reinterpret_cast<const bf16x8*>(kb+d0*2048);
    const bf16x8 b1=*reinterpret_cast<const bf16x8*>(kb+d0*2048+512);
    if(d0==0){p0=__builtin_amdgcn_mfma_f32_32x32x16_bf16(b0,qr[0],negm,0,0,0);p1=__builtin_amdgcn_mfma_f32_32x32x16_bf16(b1,qr[0],negm,0,0,0);}
    else{p0=__builtin_amdgcn_mfma_f32_32x32x16_bf16(b0,qr[d0],p0,0,0,0);p1=__builtin_amdgcn_mfma_f32_32x32x16_bf16(b1,qr[d0],p1,0,0,0);}}
}
typedef __attribute__((address_space(3))) const char* lds_cptr;
typedef short v4i16_t __attribute__((ext_vector_type(4)));
__device__ __forceinline__ void kload8(bf16x8*kf,lds_cptr kp){
  kf[0]=*(const __attribute__((address_space(3))) bf16x8*)(kp);      kf[1]=*(const __attribute__((address_space(3))) bf16x8*)(kp+512);
  kf[2]=*(const __attribute__((address_space(3))) bf16x8*)(kp+2048); kf[3]=*(const __attribute__((address_space(3))) bf16x8*)(kp+2560);
  kf[4]=*(const __attribute__((address_space(3))) bf16x8*)(kp+4096); kf[5]=*(const __attribute__((address_space(3))) bf16x8*)(kp+4608);
  kf[6]=*(const __attribute__((address_space(3))) bf16x8*)(kp+6144); kf[7]=*(const __attribute__((address_space(3))) bf16x8*)(kp+6656);
}
__device__ __forceinline__ void kload2(bf16x8*kf,lds_cptr kp,int j){ kf[2*j]=*(const __attribute__((address_space(3))) bf16x8*)(kp+j*2048); kf[2*j+1]=*(const __attribute__((address_space(3))) bf16x8*)(kp+j*2048+512); }
__device__ __forceinline__ s16x4 vtr(lds_cptr p){ return __builtin_bit_cast(s16x4,__builtin_amdgcn_ds_read_tr16_b64_v4i16((__attribute__((address_space(3))) v4i16_t*)p)); }
__device__ __forceinline__ float rowmax(const f32x16&p0,const f32x16&p1){
  float a=max3f(p0[0],p0[1],p1[0]),b=max3f(p0[2],p0[3],p1[1]);a=max3f(a,p1[2],p1[3]);
  #pragma unroll
  for(int r=4;r<16;r+=4){a=max3f(a,p0[r],p0[r+1]);b=max3f(b,p0[r+2],p0[r+3]);a=max3f(a,p1[r],p1[r+1]);b=max3f(b,p1[r+2],p1[r+3]);}
  const float m=max2f(a,b);
  auto rr=__builtin_amdgcn_permlane32_swap(__float_as_uint(m),__float_as_uint(m),false,false);
  return max2f(__uint_as_float(rr[0]),__uint_as_float(rr[1]));
}
__device__ __forceinline__ void pv(f32x16*o,int vb,bf16x8 pa0,bf16x8 pa1,bf16x8 pa2,bf16x8 pa3){
  #pragma unroll
  for(int d0=0;d0<2;++d0){s16x4 lo[4],hi[4];
    #pragma unroll
    for(int ks=0;ks<4;++ks){
      asm volatile("ds_read_b64_tr_b16 %0,%1 offset:%c2":"=&v"(lo[ks]):"v"(vb),"i"(d0*4096+ks*1024):"memory");
      asm volatile("ds_read_b64_tr_b16 %0,%1 offset:%c2":"=&v"(hi[ks]):"v"(vb),"i"(d0*4096+ks*1024+512):"memory");}
    asm volatile("s_waitcnt lgkmcnt(0)":::"memory");SBAR();
    #define PK(k) (bf16x8){lo[k][0],lo[k][1],lo[k][2],lo[k][3],hi[k][0],hi[k][1],hi[k][2],hi[k][3]}
    o[d0]=__builtin_amdgcn_mfma_f32_32x32x16_bf16(pa0,PK(0),o[d0],0,0,0);
    o[d0]=__builtin_amdgcn_mfma_f32_32x32x16_bf16(pa1,PK(1),o[d0],0,0,0);
    o[d0]=__builtin_amdgcn_mfma_f32_32x32x16_bf16(pa2,PK(2),o[d0],0,0,0);
    o[d0]=__builtin_amdgcn_mfma_f32_32x32x16_bf16(pa3,PK(3),o[d0],0,0,0);
    #undef PK
  }
}

#ifndef ATTN_STORE16
#define ATTN_STORE16(p,v) (*(u32x4*)(p)=(v))
#endif
template<int THRL> __device__ __forceinline__ void attn_unit(const bf16*Q0,bf16*O0,const bf16*__restrict__ KA,const bf16*__restrict__ VA,const bf16*__restrict__ KB,const bf16*__restrict__ VB,const int NC,const int NT,const int krelB,const float sink2,char*shm){
  int tid_=threadIdx.x; asm volatile("":"+v"(tid_));
  const int tid=tid_,lane=tid&63,r32=lane&31,hi=lane>>5; const int wid=__builtin_amdgcn_readfirstlane(tid>>6);
  const bf16*Qw=Q0+(long)(wid*QBLK)*QP;
  const unsigned lds0=(unsigned)(uintptr_t)shm;
  float*wsf=(float*)(shm+LDS_WS)+wid*64;
  const int koff=lane*KP+wid*8; const bf16*ksrcA=KA+koff,*ksrcB=KB+koff;
  const int voff=(16*(wid&3)+(lane>>2))*KP+(wid>>2)*32+(lane&3)*8; const bf16*vsrcA=VA+voff,*vsrcB=VB+voff;
  const unsigned kdst=lds0+LDS_K+wid*1024, vdst=lds0+LDS_V+wid*1024;
  #define DMA_K(t,slot) glds16(((t)<NC?ksrcA+(long)(t)*(KVBLK*KP):ksrcB+(long)((t)-NC)*(KVBLK*KP)),(unsigned)__builtin_amdgcn_readfirstlane(kdst+(slot)))
  #define DMA_V(t,slot) glds16(((t)<NC?vsrcA+(long)(t)*(KVBLK*KP):vsrcB+(long)((t)-NC)*(KVBLK*KP)),(unsigned)__builtin_amdgcn_readfirstlane(vdst+(slot)))
  const int vb0=(int)(lds0+LDS_V)+((lane>>4)&1)*32+(lane&3)*8+(4*hi+((lane&15)>>2))*64;
  const char*Kbase=shm+LDS_K; bf16x8 kf[8];
  const lds_cptr shm3=(lds_cptr)shm; const lds_cptr kp0=shm3+LDS_K+hi*1024+r32*16; const lds_cptr vp0=shm3+LDS_V+((lane>>4)&1)*32+(lane&3)*8+(4*hi+((lane&15)>>2))*64;
  DMA_K(0,0);DMA_V(0,0);DMA_K(1,SLOTB);
  bf16x8 qr[4];
  #pragma unroll
  for(int d0=0;d0<4;++d0)qr[d0]=*reinterpret_cast<const bf16x8*>(&Qw[(long)r32*QP+d0*16+hi*8]);
  float mhat=0.f,l_reg=0.f;f32x16 o[2];o[0]=f32x16{};o[1]=f32x16{};f32x16 negm=f32x16{};asm volatile("":"+v"(negm));
  const int qrel=wid*QBLK+r32;
  #define CMASK(P0,P1,t) do{ if((t)>=NC){ const int k0_=krelB+64*((t)-NC); if(!(k0_+63-wid*QBLK<=128 && wid*QBLK+31-k0_<=128)) bmask(P0,P1,k0_+4*hi-qrel); } }while(0)
  bool resc=false;
  #define START(P0,P1) do{ const float rm=rowmax(P0,P1); resc=false; \
    { const float dl=rm; mhat=fadd_s(mhat,dl); \
      _Pragma("unroll") for(int r=0;r<16;++r){P0[r]=fsub_s(P0[r],dl);P1[r]=fsub_s(P1[r],dl);} \
      _Pragma("unroll") for(int r=0;r<16;++r)negm[r]=-mhat; asm volatile("":"+v"(negm)); } \
    _Pragma("unroll") for(int r=0;r<16;++r)P0[r]=__builtin_amdgcn_exp2f(P0[r]); }while(0)
  #define RESC() do{ if(resc){ asm volatile("s_waitcnt lgkmcnt(0)":::"memory"); \
      _Pragma("unroll") for(int d_=0;d_<2;++d_) _Pragma("unroll") for(int r=0;r<16;++r)o[d_][r]*=wsf[crow(r,hi)]; } }while(0)
  f32x16 pA0,pA1,pB0,pB1;
  int sl_prev=0,sl_cur=0,sl_next=SLOTB;
  #define ROT() do{sl_prev=sl_cur;sl_cur=sl_next;sl_next=(sl_next==(NSLOT-1)*SLOTB)?0:sl_next+SLOTB;}while(0)
  DMA_K(2,2*SLOTB);
  WAIT_BAR(3);
  qkt(pA0,pA1,Kbase,qr,negm,r32,hi);asm volatile("s_nop 15\n\ts_nop 7":"+v"(pA0),"+v"(pA1));CMASK(pA0,pA1,0);
  START(pA0,pA1);
  _Pragma("unroll") for(int r=0;r<16;++r)pA1[r]=__builtin_amdgcn_exp2f(pA1[r]);
  WAIT_BAR(0);
  DMA_K(3,0);DMA_V(1,SLOTB);
  ROT();
  kload8(kf,kp0+sl_cur);
  WAIT_BAR(2);
  s16x4 vlo[8],vhi[8]; u32x4 pw0,pw1,pw2,pw3;
  #define PKW(P,B) cvtpk_s(P[B],P[B+1])
  #define PAF(k) __builtin_bit_cast(bf16x8,pw##k)
  #define VFR(i) (bf16x8){vlo[i][0],vlo[i][1],vlo[i][2],vlo[i][3],vhi[i][0],vhi[i][1],vhi[i][2],vhi[i][3]}
  #define PIN(x) asm volatile("":"+v"(x))
  #define MX3(a,b,c) __builtin_fmaxf(__builtin_fmaxf((a),(b)),(c))
  #define GAPA(MF,A0,A1,A2,A3,W0,W1,PW) do{ MF; sacc+=A0; sacc+=A1; sacc+=A2; sacc+=A3; PIN(sacc); W0; W1; PIN(PW); SBAR(); }while(0)
  #define EX(v) __builtin_amdgcn_exp2f(v)
  #define GAPB(MF,X,B) do{ MF; X[B]=EX(X[B]); X[B+1]=EX(X[B+1]); X[B+2]=EX(X[B+2]); X[B+3]=EX(X[B+3]); PIN(X); SBAR(); }while(0)
  #define VRD(i) do{ vlo[i]=vtr(vp_+(((i)>>2)*4096+((i)&3)*1024)); vhi[i]=vtr(vp_+(((i)>>2)*4096+((i)&3)*1024+512)); }while(0)
  #define KRD(G,j) do{ if(G){ kload2(kf,kp0+sl_next,j); SBAR(); } }while(0)
  #define STEP(C0,C1,P0,P1,t,GK,GV,GL) do{ SBAR(); \
    const lds_cptr vp_=vp0+sl_prev; \
    VRD(0); SBAR(); float sacc=(P0[0]+P0[1]); \
    GAPA(C0=__builtin_amdgcn_mfma_f32_32x32x16_bf16(kf[0],qr[0],negm,0,0,0), P0[2],P0[3],P0[4],P0[5],     pw0[0]=PKW(P0,0), pw0[1]=PKW(P0,2), pw0); \
    VRD(4); SBAR(); GAPA(C1=__builtin_amdgcn_mfma_f32_32x32x16_bf16(kf[1],qr[0],negm,0,0,0), P0[6],P0[7],P0[8],P0[9],     pw0[2]=PKW(P0,4), pw0[3]=PKW(P0,6), pw0); \
    VRD(1); SBAR(); GAPA(C0=__builtin_amdgcn_mfma_f32_32x32x16_bf16(kf[2],qr[1],C0,0,0,0),   P0[10],P0[11],P0[12],P0[13], pw1[0]=PKW(P0,8), pw1[1]=PKW(P0,10), pw1); \
    VRD(5); SBAR(); GAPA(C1=__builtin_amdgcn_mfma_f32_32x32x16_bf16(kf[3],qr[1],C1,0,0,0),   P0[14],P0[15],P1[0],P1[1],   pw1[2]=PKW(P0,12),pw1[3]=PKW(P0,14), pw1); \
    VRD(2); SBAR(); GAPA(C0=__builtin_amdgcn_mfma_f32_32x32x16_bf16(kf[4],qr[2],C0,0,0,0),   P1[2],P1[3],P1[4],P1[5],     pw2[0]=PKW(P1,0), pw2[1]=PKW(P1,2), pw2); \
    VRD(6); SBAR(); GAPA(C1=__builtin_amdgcn_mfma_f32_32x32x16_bf16(kf[5],qr[2],C1,0,0,0),   P1[6],P1[7],P1[8],P1[9],     pw2[2]=PKW(P1,4), pw2[3]=PKW(P1,6), pw2); \
    VRD(3); SBAR(); GAPA(C0=__builtin_amdgcn_mfma_f32_32x32x16_bf16(kf[6],qr[3],C0,0,0,0),   P1[10],P1[11],P1[12],P1[13], pw3[0]=PKW(P1,8), pw3[1]=PKW(P1,10), pw3); \
    VRD(7); SBAR(); GAPA(C1=__builtin_amdgcn_mfma_f32_32x32x16_bf16(kf[7],qr[3],C1,0,0,0),   P1[14],P1[15],0.f,0.f,       pw3[2]=PKW(P1,12),pw3[3]=PKW(P1,14), pw3); \
    l_reg+=sacc; \
    if(GK){DMA_K((t)+3,sl_cur);} if(GV){DMA_V((t)+1,sl_next);} \
    CMASK(C0,C1,t); \
    { float a=MX3(C0[0],C0[1],C1[0]),b=MX3(C0[2],C0[3],C1[1]); a=MX3(a,C1[2],C1[3]); \
      _Pragma("unroll") for(int r=4;r<16;r+=4){a=MX3(a,C0[r],C0[r+1]);b=MX3(b,C0[r+2],C0[r+3]);a=MX3(a,C1[r],C1[r+1]);b=MX3(b,C1[r+2],C1[r+3]);} \
      float rm=__builtin_fmaxf(a,b); { auto rr=__builtin_amdgcn_permlane32_swap(__float_as_uint(rm),__float_as_uint(rm),false,false); rm=__builtin_fmaxf(__uint_as_float(rr[0]),__uint_as_float(rr[1])); } \
      resc=false; \
      if(__builtin_expect(__any(rm>(float)THRL),0)){ const float dl=__builtin_fmaxf(rm,0.f); mhat+=dl; \
        _Pragma("unroll") for(int r=0;r<16;++r){C0[r]-=dl;C1[r]-=dl;} \
        _Pragma("unroll") for(int r=0;r<16;++r)negm[r]=-mhat; asm volatile("":"+v"(negm)); \
        const float f=__builtin_amdgcn_exp2f(-dl); l_reg*=f; if(hi==0)wsf[r32]=f; resc=true; } } \
    SBAR(); \
    GAPB(o[0]=__builtin_amdgcn_mfma_f32_32x32x16_bf16(PAF(0),VFR(0),o[0],0,0,0), C0,0); \
    GAPB(o[1]=__builtin_amdgcn_mfma_f32_32x32x16_bf16(PAF(0),VFR(4),o[1],0,0,0), C0,4); \
    KRD(GL,0); GAPB(o[0]=__builtin_amdgcn_mfma_f32_32x32x16_bf16(PAF(1),VFR(1),o[0],0,0,0), C0,8); \
    KRD(GL,1); GAPB(o[1]=__builtin_amdgcn_mfma_f32_32x32x16_bf16(PAF(1),VFR(5),o[1],0,0,0), C0,12); \
    KRD(GL,2); GAPB(o[0]=__builtin_amdgcn_mfma_f32_32x32x16_bf16(PAF(2),VFR(2),o[0],0,0,0), C1,0); \
    KRD(GL,3); GAPB(o[1]=__builtin_amdgcn_mfma_f32_32x32x16_bf16(PAF(2),VFR(6),o[1],0,0,0), C1,4); \
    GAPB(o[0]=__builtin_amdgcn_mfma_f32_32x32x16_bf16(PAF(3),VFR(3),o[0],0,0,0), C1,8); \
    GAPB(o[1]=__builtin_amdgcn_mfma_f32_32x32x16_bf16(PAF(3),VFR(7),o[1],0,0,0), C1,12); \
    }while(0)
  int t=1;
  #undef CMASK
  #define CMASK(P0,P1,t) do{}while(0)
  for(;t+5<NT&&t+2<=NC;t+=2){
    STEP(pB0,pB1,pA0,pA1,t,true,true,true);     WAIT_BAR(2); RESC(); ROT();
    STEP(pA0,pA1,pB0,pB1,t+1,true,true,true);   WAIT_BAR(2); RESC(); ROT();
  }
  #undef CMASK
  #define CMASK(P0,P1,t) do{ if((t)>=NC){ const int k0_=krelB+64*((t)-NC); if(!(k0_+63-wid*QBLK<=128 && wid*QBLK+31-k0_<=128)) bmask(P0,P1,k0_+4*hi-qrel); } }while(0)
  #define ENDW(tt) do{ if((tt)+3<NT){WAIT_BAR(2);} else if((tt)+2<NT){WAIT_BAR(1);} else {WAIT_BAR(0);} }while(0)
  for(;t+1<NT;t+=2){
    STEP(pB0,pB1,pA0,pA1,t,(t+3<NT),(t+1<NT),(t+1<NT));       ENDW(t);   RESC(); ROT();
    STEP(pA0,pA1,pB0,pB1,t+1,(t+4<NT),(t+2<NT),(t+2<NT));     ENDW(t+1); RESC(); ROT();
  }
  STEP(pB0,pB1,pA0,pA1,NT-1,false,false,false); RESC();
  { float sacc=pB0[0]+pB0[1]; _Pragma("unroll") for(int r=2;r<16;++r)sacc+=pB0[r]; _Pragma("unroll") for(int r=0;r<16;++r)sacc+=pB1[r]; l_reg+=sacc;
    pw0=(u32x4){PKW(pB0,0),PKW(pB0,2),PKW(pB0,4),PKW(pB0,6)};pw1=(u32x4){PKW(pB0,8),PKW(pB0,10),PKW(pB0,12),PKW(pB0,14)};pw2=(u32x4){PKW(pB1,0),PKW(pB1,2),PKW(pB1,4),PKW(pB1,6)};pw3=(u32x4){PKW(pB1,8),PKW(pB1,10),PKW(pB1,12),PKW(pB1,14)};
    SBAR(); pv(o,vb0+sl_cur,PAF(0),PAF(1),PAF(2),PAF(3)); }
  #undef PKW
  #undef PAF
  #undef VFR
  #undef PIN
  #undef MX3
  #undef GAPA
  #undef GAPB
  #undef EX
  #undef VRD
  #undef KRD
  #undef STEP
  #undef ENDW
  {auto rr=__builtin_amdgcn_permlane32_swap(__float_as_uint(l_reg),__float_as_uint(l_reg),false,false);l_reg=__uint_as_float(rr[0])+__uint_as_float(rr[1]);}
  l_reg+=__builtin_amdgcn_exp2f(sink2-mhat);
  if(hi==0)wsf[32+r32]=l_reg;asm volatile("s_waitcnt lgkmcnt(0)":::"memory");
  float rli[16];
  #pragma unroll
  for(int r=0;r<16;++r)rli[r]=__builtin_amdgcn_rcpf(wsf[32+crow(r,hi)]);
  bf16*Ow=O0+(long)(wid*QBLK)*OP;
  { bf16*stg=(bf16*)(shm+LDS_OST)+wid*2048;
    #pragma unroll
    for(int r=0;r<16;++r){const int orow=crow(r,hi);
      #pragma unroll
      for(int d0=0;d0<2;++d0)stg[orow*64+d0*32+r32]=__float2bfloat16(o[d0][r]*rli[r]);}
    asm volatile("s_waitcnt lgkmcnt(0)":::"memory");
    #pragma unroll
    for(int i=0;i<4;++i){const int row=i*8+(lane>>3),ch=lane&7; const u32x4 v=*(const u32x4*)(stg+row*64+ch*8); ATTN_STORE16(Ow+(long)row*OP+ch*8,v);} }
  asm volatile("s_waitcnt lgkmcnt(0)\n\ts_barrier":::"memory");
  #undef DMA_K
  #undef DMA_V
  #undef CMASK
  #undef START
  #undef RESC
  #undef ROT
}
constexpr int ATTN_LDS_BYTES=LDS_BYTES;
#undef SBAR
#undef WAIT_BAR
}
#define GAS __attribute__((address_space(1)))
#define LAS __attribute__((address_space(3)))
typedef unsigned short bf16;
typedef unsigned v4u __attribute__((ext_vector_type(4)));
typedef float f32x4 __attribute__((ext_vector_type(4)));
typedef short bf16x8 __attribute__((ext_vector_type(8)));
#define LDS_WAIT() asm volatile("s_waitcnt lgkmcnt(0)" ::: "memory")

constexpr int DM = 1024, MC = 4096, ML = 32768, MT = MC + ML, DFF = 2816, NIN = 1792, NWAVES = 8;
constexpr size_t MiB = 1u << 20;
constexpr size_t WS_MOD = 0;
constexpr size_t WS_ROPE = 1 * MiB;
constexpr size_t WS_WIN = 2 * MiB, WS_WOUT = 9 * MiB, WS_CK = 13 * MiB, WS_CV = 15 * MiB, WS_WFO = 17 * MiB, WS_WFI = 39 * MiB;
constexpr size_t WS_XN = 83 * MiB, WS_HID = 155 * MiB, WS_Q = 353 * MiB, WS_K = 389 * MiB, WS_V = 398 * MiB, WS_U4 = 407 * MiB, WS_END = 479 * MiB;
constexpr int LDS_BYTES = 147456;

__device__ __forceinline__ unsigned f2bf(float f) { unsigned u = __builtin_bit_cast(unsigned, f); return (u + 0x7fffu + ((u >> 16) & 1u)) >> 16; }
__device__ __forceinline__ unsigned pk2(float lo, float hi) { return f2bf(lo) | (f2bf(hi) << 16); }
__device__ __forceinline__ float bf2f(unsigned short b) { return __builtin_bit_cast(float, (unsigned)b << 16); }
__device__ __forceinline__ float wave_sum(float v) {
#pragma unroll
    for (int o = 1; o < 64; o <<= 1) v += __shfl_xor(v, o);
    return v;
}
__device__ __forceinline__ int rowmap(int mode, int n) {
    if (mode == 1) { const int up = n >= DFF; const int j = up ? n - DFF : n; return 256 * (j >> 7) + (up ? 128 : 0) + (j & 127); }
    if (mode == 2 && n < 768) { const int hd = n >> 6, d = n & 63; const int pn = hd >> 2, wc = hd & 3, bj = d >> 5, d2 = d & 31, nn = d2 >> 4, fq = (d2 & 15) >> 2, j = d2 & 3;
        return 256 * pn + 128 * bj + 32 * wc + 8 * fq + 4 * nn + j; }
    return n;
}
template <bool F8 = false> __device__ __forceinline__ void transpose_item(const float* W, int K, int N, bf16* WT, int mode, LAS float* scr, int item, int lane) {
    const int nblk = N / 32, kb = item / nblk, nb = item % nblk, k0 = 64 * kb, n0 = 32 * nb;
    if (mode == 3 && k0 >= 512 && k0 < 768) return;
#pragma unroll 8
    for (int i = 0; i < 32; ++i) { const int kk = 2 * i + (lane >> 5); scr[kk * 33 + (lane & 31)] = W[(size_t)(k0 + kk) * N + n0 + (lane & 31)]; }
    LDS_WAIT(); asm volatile("" ::: "memory");
    const int c = lane & 7;
#pragma unroll
    for (int j = 0; j < 4; ++j) { const int n = (lane >> 3) + 8 * j; const LAS float* s = scr + (8 * c) * 33 + n;
        if constexpr (F8) { unsigned long long o = (unsigned long long)pk4_fp8(s[0 * 33] * F8_SW, s[1 * 33] * F8_SW, s[2 * 33] * F8_SW, s[3 * 33] * F8_SW) | ((unsigned long long)pk4_fp8(s[4 * 33] * F8_SW, s[5 * 33] * F8_SW, s[6 * 33] * F8_SW, s[7 * 33] * F8_SW) << 32);
            *(unsigned long long*)((unsigned char*)WT + (size_t)rowmap(mode, n0 + n) * K + k0 + 8 * c) = o; }
        else { v4u o; o.x = pk2(s[0 * 33], s[1 * 33]); o.y = pk2(s[2 * 33], s[3 * 33]); o.z = pk2(s[4 * 33], s[5 * 33]); o.w = pk2(s[6 * 33], s[7 * 33]);
            *(v4u*)(WT + (size_t)rowmap(mode, n0 + n) * K + k0 + 8 * c) = o; } }
    LDS_WAIT(); asm volatile("" ::: "memory");
}
__device__ __forceinline__ void fold_item(const float* wout, const float* poolw, const float* pscale, bf16* WT, int item, int lane) {
    const int gi = item >> 5, ch = (item >> 4) & 1, n = (item & 15) * 64 + lane;
    const float* P = poolw + gi * 4096 + ch * 32 * 64;
    float a[32];
#pragma unroll
    for (int cc = 0; cc < 32; ++cc) a[cc] = 0.f;
#pragma unroll 1
    for (int d = 0; d < 64; ++d) {
        const float wv = wout[(size_t)(512 + 64 * gi + d) * 1024 + n] * pscale[64 * gi + d];
#pragma unroll
        for (int cc = 0; cc < 32; ++cc) a[cc] += P[cc * 64 + d] * wv;
    }
#pragma unroll
    for (int c0 = 0; c0 < 32; c0 += 8) {
        v4u o; o.x = pk2(a[c0], a[c0 + 1]); o.y = pk2(a[c0 + 2], a[c0 + 3]); o.z = pk2(a[c0 + 4], a[c0 + 5]); o.w = pk2(a[c0 + 6], a[c0 + 7]);
        *(v4u*)(WT + (size_t)n * 1024 + 512 + 64 * gi + ch * 32 + c0) = o;
    }
}

template <class T> __device__ __forceinline__ T* opq(T* p) { GAS T* g = (GAS T*)p; asm volatile("" : "+s"(g)); return (T*)g; }
struct Args { const float* in[19]; float* out; unsigned char* ws; };
typedef const __attribute__((address_space(4))) Args* KArgP;
__device__ __forceinline__ KArgP KARGS() { KArgP p = (KArgP)__builtin_amdgcn_kernarg_segment_ptr(); asm volatile("" : "+s"(p)); return p; }

template <bool F8> __device__ __forceinline__ void norm_rows(const float* xc, const float* xl, bf16* XN, const float* mod_l, int k, const float* g, int gw, int NGW, int lane) {
    asm volatile("" : "+v"(lane));
    for (int row = gw; row < MT; row += NGW) {
        const int cidx = row < MC ? 8 : ((row - MC) >> 12);
        const float* xrow = row < MC ? xc + (size_t)row * DM : xl + (size_t)(row - MC) * DM;
        const float* sh = mod_l + (size_t)(cidx * 9 + 3 * k) * DM; const float* sc = sh + DM;
        f32x4 v[4]; float s = 0.f;
#pragma unroll
        for (int j = 0; j < 4; ++j) { v[j] = ((const f32x4*)xrow)[lane + 64 * j]; s += (v[j].x * v[j].x + v[j].y * v[j].y) + (v[j].z * v[j].z + v[j].w * v[j].w); }
        const float rstd = 1.0f / sqrtf(wave_sum(s) * (1.0f / DM) + 1e-6f);
        unsigned long long* o8 = (unsigned long long*)(XN + (size_t)row * DM) + lane;
#pragma unroll
        for (int j = 0; j < 4; ++j) {
            const f32x4 gv = ((const f32x4*)g)[lane + 64 * j], scv = ((const f32x4*)sc)[lane + 64 * j], shv = ((const f32x4*)sh)[lane + 64 * j];
            const f32x4 h = v[j] * rstd * gv * (scv + 1.0f) + shv;
            if constexpr (F8) ((unsigned*)((unsigned char*)XN + (size_t)row * DM))[lane + 64 * j] = pk4_fp8(h.x * F8_SA, h.y * F8_SA, h.z * F8_SA, h.w * F8_SA);
            else o8[64 * j] = (unsigned long long)pk2(h.x, h.y) | ((unsigned long long)pk2(h.z, h.w) << 32);
        }
    }
}

__device__ __forceinline__ void ld8(const bf16* p, float (&f)[8]) {
    const v4u w = *(const v4u*)p;
    f[0] = __builtin_bit_cast(float, w.x << 16); f[1] = __builtin_bit_cast(float, w.x & 0xffff0000u);
    f[2] = __builtin_bit_cast(float, w.y << 16); f[3] = __builtin_bit_cast(float, w.y & 0xffff0000u);
    f[4] = __builtin_bit_cast(float, w.z << 16); f[5] = __builtin_bit_cast(float, w.z & 0xffff0000u);
    f[6] = __builtin_bit_cast(float, w.w << 16); f[7] = __builtin_bit_cast(float, w.w & 0xffff0000u);
}
__device__ __forceinline__ void poolconv_rows(const bf16* U4, bf16* MIX, const float* convw, int blk, int G, int tid) {
    asm volatile("" : "+v"(tid));
    const int sub = tid >> 6, c64 = tid & 63;
    for (int r0 = blk * 8; r0 < MT; r0 += G * 8) {
        const int r = r0 + sub;
        const int s0 = r < MC ? (r & ~255) : MC + ((r - MC) & ~4095), T = r < MC ? 256 : 4096, t = r - s0;
        if (c64 < 32) {
            const int ch = 8 * c64, gi = ch >> 6, hw = 1 << gi;
            const int lo = t - hw < 0 ? 0 : t - hw, hi = t + hw > T ? T : t + hw;
            float acc[8] = {0.f, 0.f, 0.f, 0.f, 0.f, 0.f, 0.f, 0.f}, f[8];
            for (int j = lo; j < hi; ++j) { ld8(U4 + (size_t)(s0 + j) * 1024 + ch, f);
#pragma unroll
                for (int e = 0; e < 8; ++e) acc[e] += f[e]; }
            ld8(U4 + (size_t)r * 1024 + ch, f);
            const float inv = 1.0f / (float)(hi - lo);
            v4u o; o.x = pk2(acc[0] * inv - f[0], acc[1] * inv - f[1]); o.y = pk2(acc[2] * inv - f[2], acc[3] * inv - f[3]);
            o.z = pk2(acc[4] * inv - f[4], acc[5] * inv - f[5]); o.w = pk2(acc[6] * inv - f[6], acc[7] * inv - f[7]);
            *(v4u*)(MIX + (size_t)r * 1024 + 512 + ch) = o;
        } else {
            const int ch = 8 * (c64 - 32);
            float um[8], u0[8], up[8], cm[8], c0[8], cp[8], bg[8], y[8];
            const bf16* base = U4 + (size_t)r * 1024;
            ld8(base + 256 + ch, u0); ld8(base + 768 + ch, c0); ld8(base + 512 + ch, bg);
            if (t > 0) { ld8(base - 1024 + 256 + ch, um); ld8(base - 1024 + 768 + ch, cm); }
            if (t < T - 1) { ld8(base + 1024 + 256 + ch, up); ld8(base + 1024 + 768 + ch, cp); }
#pragma unroll
            for (int e = 0; e < 8; ++e) {
                const float zm = t > 0 ? um[e] * cm[e] : 0.f, zp = t < T - 1 ? up[e] * cp[e] : 0.f;
                y[e] = bg[e] * (zm * convw[ch + e] + u0[e] * c0[e] * convw[256 + ch + e] + zp * convw[512 + ch + e]);
            }
            v4u o; o.x = pk2(y[0], y[1]); o.y = pk2(y[2], y[3]); o.z = pk2(y[4], y[5]); o.w = pk2(y[6], y[7]);
            *(v4u*)(MIX + (size_t)r * 1024 + 768 + ch) = o;
        }
    }
}

#define ws ((unsigned char*)(GAS unsigned char*)(KARGS()->ws))
#define x_prompt ((const float*)(const GAS float*)(KARGS()->in[0]))
#define x_sample ((const float*)(const GAS float*)(KARGS()->in[1]))
#define cache_k ((const float*)(const GAS float*)(KARGS()->in[2]))
#define cache_v ((const float*)(const GAS float*)(KARGS()->in[3]))
#define cvec ((const float*)(const GAS float*)(KARGS()->in[4]))
#define c_ctx ((const float*)(const GAS float*)(KARGS()->in[5]))
#define w_ada ((const float*)(const GAS float*)(KARGS()->in[6]))
#define b_ada ((const float*)(const GAS float*)(KARGS()->in[7]))
#define norm_g ((const float*)(const GAS float*)(KARGS()->in[8]))
#define w_ffn_in ((const float*)(const GAS float*)(KARGS()->in[9]))
#define w_ffn_out ((const float*)(const GAS float*)(KARGS()->in[10]))
#define w_in ((const float*)(const GAS float*)(KARGS()->in[11]))
#define w_out ((const float*)(const GAS float*)(KARGS()->in[12]))
#define q_norm_g ((const float*)(const GAS float*)(KARGS()->in[13]))
#define k_norm_g ((const float*)(const GAS float*)(KARGS()->in[14]))
#define sink ((const float*)(const GAS float*)(KARGS()->in[15]))
#define pool_w ((const float*)(const GAS float*)(KARGS()->in[16]))
#define pool_scale ((const float*)(const GAS float*)(KARGS()->in[17]))
#define conv_w ((const float*)(const GAS float*)(KARGS()->in[18]))
#define mod ((float*)(opq(ws) + WS_MOD))
#define ropeC ((float*)(opq(ws) + WS_ROPE))
#define ropeS (ropeC + 1024)
#define WIN ((bf16*)(opq(ws) + WS_WIN))
#define WOUT ((bf16*)(opq(ws) + WS_WOUT))
#define CK ((bf16*)(opq(ws) + WS_CK))
#define CV ((bf16*)(opq(ws) + WS_CV))
#define WFO ((bf16*)(opq(ws) + WS_WFO))
#define WFI ((bf16*)(opq(ws) + WS_WFI))
#define XN ((bf16*)(opq(ws) + WS_XN))
#define HID ((bf16*)(opq(ws) + WS_HID))
#define QB ((bf16*)(opq(ws) + WS_Q))
#define KB ((bf16*)(opq(ws) + WS_K))
#define VB ((bf16*)(opq(ws) + WS_V))
#define U4 ((bf16*)(opq(ws) + WS_U4))
#define out ((float*)(GAS float*)(KARGS()->out))
#define newk (out + (size_t)MT * DM)
#define newv (newk + (size_t)16 * 2 * 256 * 128)

template <int l> __device__ __forceinline__ void layer_body(LAS unsigned char* L, unsigned char* lds, int tid, int lane, int blk, int G, int gw, int NGW, cg::grid_group& grid) {
        const float* mod_l = mod + (size_t)l * 9 * 9216;
        const float* xc_in = l == 0 ? x_prompt : out; const float* xl_in = l == 0 ? x_sample : out + (size_t)MC * DM;
#ifndef NO_NORM
        norm_rows<true>(xc_in, xl_in, XN, mod_l, 0, norm_g + (l * 3 + 0) * DM, gw, NGW, lane);
#endif
        grid.sync();
#ifndef NO_G1
        { pg8::Gemm g{XN, WFI + (size_t)(l * 2 + 0) * 5632 * 512, MT, 5632, 512}; pg8::StaticOrder S; S.init(MT, 5632, G, blk); pg8::EpiSwiGLU<true> E{HID};
          pg8::gemm_phase<pg8::EpiSwiGLU<true>, pg8::StaticOrder, true, true, true>(L, g, S, E); }
#endif
        grid.sync();
#ifndef NO_G2
        { pg8::Gemm g{HID, WFO + (size_t)(l * 2 + 0) * 1024 * 1408, MT, 1024, 1408}; pg8::StaticOrder S; S.init(MT, 1024, G, blk); pg8::EpiResid E{xc_in, xl_in, out, mod_l + 2 * DM, 0.5f / (F8_SH * F8_SW)};
          pg8::gemm_phase<pg8::EpiResid, pg8::StaticOrder, true, true, true>(L, g, S, E); }
#endif
        grid.sync();
#ifndef NO_NORM
        norm_rows<false>(out, out + (size_t)MC * DM, XN, mod_l, 1, norm_g + (l * 3 + 1) * DM, gw, NGW, lane);
#endif
        grid.sync();
#ifndef NO_G3
        { pg8::Gemm g{XN, WIN + (size_t)l * NIN * 1024, MT, NIN, 1024}; pg8::StaticOrder S; S.init(MT, NIN, G, blk);
          pg8::EpiIn E{QB, KB, VB, U4, newk + (size_t)l * 256 * 128, newv + (size_t)l * 256 * 128, q_norm_g + l * 64, k_norm_g + l * 64, ropeC, ropeS};
          pg8::gemm_phase<pg8::EpiIn, pg8::StaticOrder, true, true>(L, g, S, E); }
#endif
        grid.sync();
        {
            bf16* MIX = XN;
            const float LOG2E = 1.4426950408889634f;
#ifndef NO_ATT
            for (int i = 0; i < 5; ++i) {
                const int idx = blk + i * G;
                if (idx < 1024) {
                    const int qb = idx & 15, h = (idx >> 4) & 7, b = idx >> 7, kvh = h >> 2, q0 = qb * 256;
                    const int kstart = q0 - 128 < 0 ? 0 : q0 - 128, kend = q0 + 384 > 4096 ? 4096 : q0 + 384;
                    const size_t row0 = (size_t)MC + (size_t)b * 4096 + q0;
                    const size_t crow0 = (size_t)(b * 2 + l) * 512;
                    const size_t krow0 = (size_t)MC + (size_t)b * 4096 + kstart;
                    attn_body::attn_unit<8>((const attn_body::bf16*)(QB + row0 * 512 + h * 64), (attn_body::bf16*)(MIX + row0 * 1024 + h * 64),
                        (const attn_body::bf16*)(CK + crow0 * 128 + kvh * 64), (const attn_body::bf16*)(CV + crow0 * 128 + kvh * 64),
                        (const attn_body::bf16*)(KB + krow0 * 128 + kvh * 64), (const attn_body::bf16*)(VB + krow0 * 128 + kvh * 64),
                        8, 8 + (kend - kstart) / 64, kstart - q0, sink[l * 8 + h] * LOG2E, (char*)lds);
                } else if (idx < 1152) {
                    const int j = idx - 1024, h = j & 7, b = j >> 3, kvh = h >> 2;
                    const size_t row0 = (size_t)b * 256;
                    attn_body::attn_unit<8>((const attn_body::bf16*)(QB + row0 * 512 + h * 64), (attn_body::bf16*)(MIX + row0 * 1024 + h * 64),
                        (const attn_body::bf16*)(KB + row0 * 128 + kvh * 64), (const attn_body::bf16*)(VB + row0 * 128 + kvh * 64),
                        (const attn_body::bf16*)(KB + row0 * 128 + kvh * 64), (const attn_body::bf16*)(VB + row0 * 128 + kvh * 64),
                        4, 4, 0, sink[l * 8 + h] * LOG2E, (char*)lds);
                }
            }
#endif
#ifndef NO_PC
            poolconv_rows(U4, MIX, conv_w + l * 768, blk, G, tid);
#endif
        }
        grid.sync();
#ifndef NO_G2
        { pg8::Gemm g{XN, WOUT + (size_t)l * 1024 * 1024, MT, 1024, 1024}; pg8::StaticOrder S; S.init(MT, 1024, G, blk); pg8::EpiResid E{out, out + (size_t)MC * DM, out, mod_l + 5 * DM, 1.0f};
          pg8::gemm_phase<pg8::EpiResid, pg8::StaticOrder, true, true>(L, g, S, E); }
#endif
        grid.sync();
#ifndef NO_NORM
        norm_rows<true>(out, out + (size_t)MC * DM, XN, mod_l, 2, norm_g + (l * 3 + 2) * DM, gw, NGW, lane);
#endif
        grid.sync();
#ifndef NO_G1
        { pg8::Gemm g{XN, WFI + (size_t)(l * 2 + 1) * 5632 * 512, MT, 5632, 512}; pg8::StaticOrder S; S.init(MT, 5632, G, blk); pg8::EpiSwiGLU<true> E{HID};
          pg8::gemm_phase<pg8::EpiSwiGLU<true>, pg8::StaticOrder, true, true, true>(L, g, S, E); }
#endif
        grid.sync();
#ifndef NO_G2
        { pg8::Gemm g{HID, WFO + (size_t)(l * 2 + 1) * 1024 * 1408, MT, 1024, 1408}; pg8::StaticOrder S; S.init(MT, 1024, G, blk); pg8::EpiResid E{out, out + (size_t)MC * DM, out, mod_l + 8 * DM, 0.5f / (F8_SH * F8_SW)};
          pg8::gemm_phase<pg8::EpiResid, pg8::StaticOrder, true, true, true>(L, g, S, E); }
#endif
        if (l == 0) grid.sync();
    }

__global__ void __launch_bounds__(NWAVES * 64, 2) fwd_mega(Args args) {
    extern __shared__ __attribute__((aligned(16))) unsigned char lds[];
    cg::grid_group grid = cg::this_grid();
    LAS unsigned char* L = (LAS unsigned char*)lds;
    const int tid = threadIdx.x, lane = tid & 63, wave = __builtin_amdgcn_readfirstlane(tid >> 6);
    const int G = gridDim.x, blk = blockIdx.x, gw = blk * NWAVES + wave, NGW = G * NWAVES;
#ifndef NO_P0
    {
        LAS float* sct = (LAS float*)(L + 69632);
        for (int i = tid; i < 9 * 1024; i += 512) { const float v = i < 8192 ? cvec[i] : c_ctx[i - 8192]; sct[i] = v / (1.0f + __expf(-v)); }
        __syncthreads();
        LAS float* scr = (LAS float*)(L + wave * 8448);
        constexpr int I_FI = 16 * 176, I_FO = 44 * 32, I_IN = 16 * 56, I_OUT = 16 * 32, I_FOLD = 128, I_MOD = 144;
        constexpr int NIT = 4 * I_FI + 4 * I_FO + 2 * I_IN + 2 * I_OUT + 2 * I_FOLD + 2 * I_MOD;
        for (int it = gw; it < NIT; it += NGW) {
            int r = it;
            if (r < 2 * I_MOD) {
                const int l = r / I_MOD, j = (r % I_MOD) * 64 + lane;
                const float* wp = w_ada + (size_t)l * 1024 * 9216 + j;
                float a[9] = {0.f, 0.f, 0.f, 0.f, 0.f, 0.f, 0.f, 0.f, 0.f};
                for (int k = 0; k < 1024; k += 4) {
                    const float w0 = wp[(size_t)k * 9216], w1 = wp[(size_t)(k + 1) * 9216], w2 = wp[(size_t)(k + 2) * 9216], w3 = wp[(size_t)(k + 3) * 9216];
#pragma unroll
                    for (int ci = 0; ci < 9; ++ci) { const f32x4 s = *(const LAS f32x4*)(sct + ci * 1024 + k); a[ci] += (s.x * w0 + s.y * w1) + (s.z * w2 + s.w * w3); }
                }
                const float bb = b_ada[l * 9216 + j];
#pragma unroll
                for (int ci = 0; ci < 9; ++ci) mod[((size_t)l * 9 + ci) * 9216 + j] = a[ci] + bb;
                continue;
            }
            r -= 2 * I_MOD;
            if (r < 2 * I_FOLD) { const int l = r / I_FOLD; fold_item(w_out + (size_t)l * 1024 * 1024, pool_w + l * 4 * 4096, pool_scale + l * 256, WOUT + (size_t)l * 1024 * 1024, r % I_FOLD, lane); continue; }
            r -= 2 * I_FOLD;
            if (r < 4 * I_FI) { const int mi = r / I_FI; transpose_item<true>(w_ffn_in + (size_t)mi * 1024 * 5632, 1024, 5632, WFI + (size_t)mi * 5632 * 512, 1, scr, r % I_FI, lane); continue; }
            r -= 4 * I_FI;
            if (r < 4 * I_FO) { const int mi = r / I_FO; transpose_item<true>(w_ffn_out + (size_t)mi * 2816 * 1024, 2816, 1024, WFO + (size_t)mi * 1024 * 1408, 0, scr, r % I_FO, lane); continue; }
            r -= 4 * I_FO;
            if (r < 2 * I_IN) { const int l = r / I_IN; transpose_item(w_in + (size_t)l * 1024 * NIN, 1024, NIN, WIN + (size_t)l * NIN * 1024, 2, scr, r % I_IN, lane); continue; }
            r -= 2 * I_IN;
            { const int l = r / I_OUT; transpose_item(w_out + (size_t)l * 1024 * 1024, 1024, 1024, WOUT + (size_t)l * 1024 * 1024, 3, scr, r % I_OUT, lane); }
        }
        for (size_t i = (size_t)blk * 512 + tid; i < (size_t)2 * 262144; i += (size_t)G * 512) {
            const bool isv = i >= 262144; const size_t e = (isv ? i - 262144 : i) * 4;
            const f32x4 v = *(const f32x4*)((isv ? cache_v : cache_k) + e);
            *(unsigned long long*)((isv ? CV : CK) + e) = (unsigned long long)pk2(v.x, v.y) | ((unsigned long long)pk2(v.z, v.w) << 32);
        }
        if (blk == 0) for (int i = tid; i < 1024; i += 512) { const int p = i >> 4, fi = i & 15; const float inv = powf(10000.0f, -(float)(2 * fi) / 32.0f); const float ang = (float)p * inv; ropeC[i] = cosf(ang); ropeS[i] = sinf(ang); }
    }
#endif
    grid.sync();

    layer_body<0>(L, lds, tid, lane, blk, G, gw, NGW, grid);
    layer_body<1>(L, lds, tid, lane, blk, G, gw, NGW, grid);
}

#undef out
#undef mod
#undef x_prompt
#undef x_sample
#undef cache_k
#undef cache_v
#undef cvec
#undef c_ctx
#undef w_ada
#undef b_ada
#undef norm_g
#undef w_ffn_in
#undef w_ffn_out
#undef w_in
#undef w_out
#undef q_norm_g
#undef k_norm_g
#undef sink
#undef pool_w
#undef pool_scale
#undef conv_w
#undef ws
extern "C" void kernel_launch(void* const* d_in, const int* in_sizes, int n_in, void* d_out, int out_size, void* d_ws, size_t ws_size, hipStream_t stream) {
    static int grid = 0;
    if (grid == 0) {
        int dev = 0, cus = 0, per_cu = 0;
        (void)hipGetDevice(&dev);
        (void)hipDeviceGetAttribute(&cus, hipDeviceAttributeMultiprocessorCount, dev);
        (void)hipFuncSetAttribute((const void*)fwd_mega, hipFuncAttributeMaxDynamicSharedMemorySize, LDS_BYTES);
        (void)hipOccupancyMaxActiveBlocksPerMultiprocessor(&per_cu, (const void*)fwd_mega, NWAVES * 64, LDS_BYTES);
        if (n_in != 19 || ws_size < WS_END) fprintf(stderr, "kernel_launch: unexpected n_in %d or ws_size %zu\n", n_in, ws_size);
        if (per_cu < 1) fprintf(stderr, "kernel_launch: occupancy query says %d blocks/CU\n", per_cu);
        grid = cus > 0 ? cus : 256;
    }
    Args a{};
    for (int i = 0; i < 19; ++i) a.in[i] = (const float*)d_in[i];
    a.out = (float*)d_out; a.ws = (unsigned char*)d_ws;
    void* kargs[] = {&a};
    hipError_t e = hipLaunchCooperativeKernel((const void*)fwd_mega, dim3(grid), dim3(NWAVES * 64), kargs, LDS_BYTES, stream);
    if (e != hipSuccess) fprintf(stderr, "cooperative launch failed: %s (grid %d)\n", hipGetErrorString(e), grid);
}
```
